# Optimizing an MI355X kernel written in HIP

```python
import jax, jax.numpy as jnp
from jax import lax
import numpy as np

D_MODEL = 1024
BATCH = 2
SEQ = 16384
DEPTH = 1
DEC_BATCH = 32
DEC_SEQ = 32
PAST_LEN = 2048

CHUNK = 64
P_DIM = 256
N_HEADS_A = 8
HEAD_DK = 128
HEAD_DV = 128
KEY_DIM = N_HEADS_A * HEAD_DK
VAL_DIM = N_HEADS_A * HEAD_DV
QKV_DIM = 2 * KEY_DIM + VAL_DIM
CONV_A = 4
WIDTH_B = D_MODEL
CONV_B = 3
ALPHA = (2 * DEPTH) ** 0.25
BETA_INIT = (8 * DEPTH) ** -0.25
LN_EPS = 1e-5
RMS_EPS = 1e-6
L2_EPS = 1e-6

OFF_ZA = QKV_DIM
OFF_BETA = OFF_ZA + VAL_DIM
OFF_DECAY = OFF_BETA + N_HEADS_A
OFF_BB = OFF_DECAY + N_HEADS_A
OFF_CB = OFF_BB + WIDTH_B
OFF_UB = OFF_CB + WIDTH_B
OFF_ZB = OFF_UB + WIDTH_B
OFF_GATE = OFF_ZB + WIDTH_B
IN_DIM = OFF_GATE + 2 * D_MODEL

kernel_name = 'hybrid_gdn_shortconv_stream'


def layer_norm(x, g, b):
    xf = x.astype(jnp.float32)
    mu = jnp.mean(xf, -1, keepdims=True)
    var = jnp.mean(jnp.square(xf - mu), -1, keepdims=True)
    return ((xf - mu) * lax.rsqrt(var + LN_EPS) * g.astype(jnp.float32) + b.astype(jnp.float32)).astype(x.dtype)


def l2norm(x):
    return x * lax.rsqrt(jnp.sum(x * x, -1, keepdims=True) + L2_EPS)


def causal_dwconv(u, buf, w):
    k_w = w.shape[0]
    t = u.shape[1]
    full = jnp.concatenate([buf.astype(u.dtype), u], axis=1)
    y = full[:, 0:t] * w[0]
    for j in range(1, k_w):
        y = y + full[:, j:j + t] * w[j]
    return y, full[:, t:]


def gated_delta_chunked(q, k, v, beta, g, s0, chunk):
    bsz, t, h, dk = q.shape
    dv = v.shape[-1]
    n = t // chunk

    def blk(a):
        a = a.reshape((bsz, n, chunk, h) + a.shape[3:])
        return jnp.moveaxis(a, 3, 1)

    q, k, v, beta, g = blk(q), blk(k), blk(v), blk(beta), blk(g)
    gc = jnp.cumsum(g, axis=-1)
    causal = jnp.tril(jnp.ones((chunk, chunk), bool))
    strict = jnp.tril(jnp.ones((chunk, chunk), bool), -1)
    diff = gc[..., :, None] - gc[..., None, :]
    decay = jnp.where(causal, jnp.exp(jnp.where(causal, diff, 0.0)), 0.0)
    kk = jnp.einsum('bhnid,bhnjd->bhnij', k, k)
    a_mat = jnp.where(strict, beta[..., :, None] * kk * decay, 0.0)
    eye = jnp.eye(chunk, dtype=jnp.float32)
    t_mat = lax.linalg.triangular_solve(eye + a_mat, jnp.broadcast_to(eye, a_mat.shape),
                                        left_side=True, lower=True, unit_diagonal=True)
    u_blk = jnp.einsum('bhnij,bhnje->bhnie', t_mat, v * beta[..., None])
    w_blk = jnp.einsum('bhnij,bhnjd->bhnid', t_mat, k * (beta * jnp.exp(gc))[..., None])
    qk = jnp.where(causal, jnp.einsum('bhnid,bhnjd->bhnij', q, k) * decay, 0.0)
    q_dec = q * jnp.exp(gc)[..., None]
    k_dec = k * jnp.exp(gc[..., -1:] - gc)[..., None]
    g_last = jnp.exp(gc[..., -1])

    def step(s, xs):
        u_c, w_c, qk_c, qd_c, kd_c, gl_c = xs
        v_new = u_c - jnp.einsum('bhid,bhde->bhie', w_c, s)
        o_c = jnp.einsum('bhid,bhde->bhie', qd_c, s) + jnp.einsum('bhij,bhje->bhie', qk_c, v_new)
        s = s * gl_c[..., None, None] + jnp.einsum('bhid,bhie->bhde', kd_c, v_new)
        return s, o_c

    xs = tuple(jnp.moveaxis(a, 2, 0) for a in (u_blk, w_blk, qk, q_dec, k_dec, g_last))
    s_fin, o = lax.scan(step, s0, xs)
    o = jnp.moveaxis(o, 0, 2)
    o = jnp.moveaxis(o, 1, 3).reshape(bsz, t, h, dv)
    return o, s_fin


def trunk_layer(h, p, conv_a_buf, s_gdn, conv_b_buf, chunk, w_in, w_conv_a, a_log, dt_bias,
                norm_a_g, w_conv_b, w_proj_a, w_proj_b, w_out, ln1_g, ln1_b, w_ple, w_ple_gate,
                ln2_g, ln2_b):
    f32 = jnp.float32
    bsz, t = h.shape[0], h.shape[1]
    z = h @ w_in
    qkv, conv_a_new = causal_dwconv(z[..., :QKV_DIM], conv_a_buf, w_conv_a)
    qkv = jax.nn.silu(qkv).astype(f32)
    q = l2norm(qkv[..., :KEY_DIM].reshape(bsz, t, N_HEADS_A, HEAD_DK)) * (HEAD_DK ** -0.5)
    k = l2norm(qkv[..., KEY_DIM:2 * KEY_DIM].reshape(bsz, t, N_HEADS_A, HEAD_DK))
    v = qkv[..., 2 * KEY_DIM:].reshape(bsz, t, N_HEADS_A, HEAD_DV)
    beta = jax.nn.sigmoid(z[..., OFF_BETA:OFF_DECAY].astype(f32))
    g = -jnp.exp(a_log.astype(f32)) * jax.nn.softplus(z[..., OFF_DECAY:OFF_BB].astype(f32) + dt_bias.astype(f32))
    o, s_new = gated_delta_chunked(q, k, v, beta, g, s_gdn.astype(f32), chunk)
    gate_a = z[..., OFF_ZA:OFF_BETA].astype(f32).reshape(bsz, t, N_HEADS_A, HEAD_DV)
    o = o * lax.rsqrt(jnp.mean(o * o, -1, keepdims=True) + RMS_EPS) * norm_a_g.astype(f32) * jax.nn.silu(gate_a)
    y_a = o.reshape(bsz, t, VAL_DIM).astype(h.dtype)
    cu = z[..., OFF_CB:OFF_UB] * z[..., OFF_UB:OFF_ZB]
    conv_b_out, conv_b_new = causal_dwconv(cu, conv_b_buf, w_conv_b)
    y_b = z[..., OFF_BB:OFF_CB] * conv_b_out * jax.nn.silu(z[..., OFF_ZB:OFF_GATE])
    gates = jax.nn.sigmoid(z[..., OFF_GATE:])
    merged = gates[..., :D_MODEL] * (y_a @ w_proj_a) + gates[..., D_MODEL:] * (y_b @ w_proj_b)
    h1 = layer_norm(ALPHA * h + merged @ w_out, ln1_g, ln1_b)
    ple = jax.nn.sigmoid(h1 @ w_ple_gate) * (p @ w_ple)
    h2 = layer_norm(ALPHA * h1 + ple, ln2_g, ln2_b)
    return h2, conv_a_new, s_new.astype(s_gdn.dtype), conv_b_new


def setup_inputs(seed: int = 0) -> dict:
    key = jax.random.key(seed)
    ks = jax.random.split(key, 32)
    nrm = jax.random.normal
    d = D_MODEL
    dt = jnp.exp(jax.random.uniform(ks[10], (DEPTH, N_HEADS_A), minval=np.log(1e-3), maxval=np.log(1e-1)))
    return {
        'x_prompt': nrm(ks[0], (BATCH, SEQ, d), jnp.float32),
        'x_sample': nrm(ks[1], (DEC_BATCH, DEC_SEQ, d), jnp.float32),
        'state_conv_a': nrm(ks[2], (DEPTH, DEC_BATCH, CONV_A - 1, QKV_DIM), jnp.float32),
        'state_gdn': 0.1 * nrm(ks[3], (DEPTH, DEC_BATCH, N_HEADS_A, HEAD_DK, HEAD_DV), jnp.float32),
        'state_conv_b': nrm(ks[4], (DEPTH, DEC_BATCH, CONV_B - 1, WIDTH_B), jnp.float32),
        'p_prompt': nrm(ks[5], (DEPTH, BATCH, SEQ, P_DIM), jnp.float32),
        'p_sample': nrm(ks[6], (DEPTH, DEC_BATCH, DEC_SEQ, P_DIM), jnp.float32),
        'ln_in_g': 1.0 + 0.01 * nrm(ks[7], (d,), jnp.float32),
        'ln_in_b': 0.01 * nrm(ks[8], (d,), jnp.float32),
        'w_in': nrm(ks[9], (DEPTH, d, IN_DIM), jnp.float32) * d ** -0.5,
        'w_conv_a': nrm(ks[11], (DEPTH, CONV_A, QKV_DIM), jnp.float32) * CONV_A ** -0.5,
        'a_log': jnp.log(jax.random.uniform(ks[12], (DEPTH, N_HEADS_A), minval=1.0, maxval=16.0)),
        'dt_bias': dt + jnp.log(-jnp.expm1(-dt)),
        'norm_a_g': 1.0 + 0.01 * nrm(ks[13], (DEPTH, HEAD_DV), jnp.float32),
        'w_conv_b': nrm(ks[14], (DEPTH, CONV_B, WIDTH_B), jnp.float32) * CONV_B ** -0.5,
        'w_proj_a': nrm(ks[15], (DEPTH, VAL_DIM, d), jnp.float32) * VAL_DIM ** -0.5 * BETA_INIT,
        'w_proj_b': nrm(ks[16], (DEPTH, WIDTH_B, d), jnp.float32) * WIDTH_B ** -0.5 * BETA_INIT,
        'w_out': nrm(ks[17], (DEPTH, d, d), jnp.float32) * d ** -0.5 * BETA_INIT,
        'ln1_g': 1.0 + 0.01 * nrm(ks[18], (DEPTH, d), jnp.float32),
        'ln1_b': 0.01 * nrm(ks[19], (DEPTH, d), jnp.float32),
        'w_ple': nrm(ks[20], (DEPTH, P_DIM, d), jnp.float32) * P_DIM ** -0.5 * BETA_INIT,
        'w_ple_gate': nrm(ks[21], (DEPTH, d, d), jnp.float32) * d ** -0.5,
        'ln2_g': 1.0 + 0.01 * nrm(ks[22], (DEPTH, d), jnp.float32),
        'ln2_b': 0.01 * nrm(ks[23], (DEPTH, d), jnp.float32),
    }


def reference(x_prompt, x_sample, state_conv_a, state_gdn, state_conv_b, p_prompt, p_sample,
              ln_in_g, ln_in_b, w_in, w_conv_a, a_log, dt_bias, norm_a_g, w_conv_b, w_proj_a,
              w_proj_b, w_out, ln1_g, ln1_b, w_ple, w_ple_gate, ln2_g, ln2_b):
    def encode(x, p, conv_a, s_gdn, conv_b, chunk):
        h = layer_norm(x, ln_in_g, ln_in_b)
        new_a, new_s, new_b = [], [], []
        for i in range(DEPTH):
            h, ca, s, cb = trunk_layer(h, p[i], conv_a[i], s_gdn[i], conv_b[i], chunk, w_in[i],
                                       w_conv_a[i], a_log[i], dt_bias[i], norm_a_g[i], w_conv_b[i],
                                       w_proj_a[i], w_proj_b[i], w_out[i], ln1_g[i], ln1_b[i],
                                       w_ple[i], w_ple_gate[i], ln2_g[i], ln2_b[i])
            new_a.append(ca)
            new_s.append(s)
            new_b.append(cb)
        return h, jnp.stack(new_a), jnp.stack(new_s), jnp.stack(new_b)

    bp = x_prompt.shape[0]
    zero_a = jnp.zeros((DEPTH, bp, CONV_A - 1, QKV_DIM), x_prompt.dtype)
    zero_s = jnp.zeros((DEPTH, bp, N_HEADS_A, HEAD_DK, HEAD_DV), state_gdn.dtype)
    zero_b = jnp.zeros((DEPTH, bp, CONV_B - 1, WIDTH_B), x_prompt.dtype)
    y_prompt, ca_p, s_p, cb_p = encode(x_prompt, p_prompt, zero_a, zero_s, zero_b, CHUNK)
    y_sample, ca_s, s_s, cb_s = encode(x_sample, p_sample, state_conv_a, state_gdn, state_conv_b,
                                       x_sample.shape[1])
    return (y_prompt, y_sample, ca_p, s_p, cb_p, ca_s, s_s, cb_s)
```

```cpp
#include <hip/hip_runtime.h>
#include <hip/hip_cooperative_groups.h>
#include <cstdio>
namespace cg = cooperative_groups;

#ifndef DBG_SKIP
#define DBG_SKIP 0
#endif
#ifndef REP_PH
#define REP_PH -1
#endif
#ifndef REP_N
#define REP_N 1
#endif
#ifndef MK_MULTI
#define MK_MULTI 0
#endif

#define LAS __attribute__((address_space(3)))
typedef unsigned short bf16_t;
typedef short bf16x8 __attribute__((ext_vector_type(8)));
typedef float f32x4 __attribute__((ext_vector_type(4)));
typedef unsigned u32x4 __attribute__((ext_vector_type(4)));
typedef unsigned u32x2 __attribute__((ext_vector_type(2)));

constexpr int MROWS = 33792, SEGM = 8448, NSEG = 4, DM = 1024, NZ = 10496, PD = 256;
constexpr float ALPHA_C = 1.189207115002721f;
constexpr int NPH = 15;
constexpr int LDS_BYTES = 131072 + 16;
constexpr size_t O_Y = 0, O_CAP = 34603008, O_SP = 34621440, O_CBP = 34883584, O_CAS = 34887680, O_SS = 35182592, O_CBS = 39376896;
constexpr size_t W_WIN = 0;
constexpr size_t W_WA = W_WIN + (size_t)NZ * 1024 * 2;
constexpr size_t W_WB = W_WA + 2097152, W_WO = W_WB + 2097152, W_WG = W_WO + 2097152;
constexpr size_t W_WP = W_WG + 2097152;
constexpr size_t W_PBF = W_WP + 524288;
constexpr size_t W_HBF = W_PBF + (size_t)MROWS * 256 * 2;
constexpr size_t W_BUFA = W_HBF + (size_t)MROWS * 2048;
constexpr size_t W_BUFB = W_BUFA + (size_t)MROWS * 2048;
constexpr size_t W_ZQ = W_BUFB + (size_t)MROWS * 2048;
constexpr size_t W_ZB4 = W_ZQ + (size_t)SEGM * 3072 * 2;
constexpr size_t W_BD = W_ZB4 + (size_t)SEGM * 4096 * 2;
constexpr size_t W_OPS = W_BD + (size_t)SEGM * 64;
constexpr size_t OPS_ITEM = 73728;
constexpr size_t W_GL = W_OPS + 1088 * OPS_ITEM;
constexpr size_t W_OSEG = W_GL + 8192;
constexpr size_t W_HISTA = W_OSEG + (size_t)SEGM * 2048;
constexpr size_t W_HISTB = W_HISTA + 5 * 2 * 3 * 3072 * 4;
constexpr size_t W_BAR = W_HISTB + 5 * 2 * 2 * 1024 * 4;
constexpr size_t W_END = W_BAR + 16384;

struct Params { const float* in[24]; float* out; unsigned char* ws; int ph_lo, ph_hi; };

typedef __bf16 bf16x2_t __attribute__((ext_vector_type(2)));
typedef float f32x2_t __attribute__((ext_vector_type(2)));
__device__ __forceinline__ unsigned cvt_pk_bf16(float lo, float hi) { f32x2_t v = {lo, hi}; bf16x2_t b = __builtin_convertvector(v, bf16x2_t); return __builtin_bit_cast(unsigned, b); }
__device__ __forceinline__ float bf_lo(unsigned u) { return __uint_as_float(u << 16); }
__device__ __forceinline__ float bf_hi(unsigned u) { return __uint_as_float(u & 0xffff0000u); }
__device__ __forceinline__ float sigmoidf_(float x) { return __builtin_amdgcn_rcpf(1.0f + __expf(-x)); }
__device__ __forceinline__ float siluf_(float x) { return x * __builtin_amdgcn_rcpf(1.0f + __expf(-x)); }
__device__ __forceinline__ int opaque_tid() { int t = threadIdx.x; asm volatile("" : "+v"(t)); return t; }
__device__ __forceinline__ void lds_barrier() { asm volatile("s_waitcnt lgkmcnt(0)" ::: "memory"); __builtin_amdgcn_s_barrier(); asm volatile("" ::: "memory"); }
__device__ __forceinline__ float wave_sum(float v) {
#pragma unroll
    for (int m = 32; m >= 1; m >>= 1) v += __shfl_xor(v, m);
    return v;
}
__device__ __forceinline__ int row2tok(int r) { const int s = r / SEGM, l = r - s * SEGM; if (l < 4096) return 4096 * s + l; if (l < 8192) return 16384 + 4096 * s + (l - 4096); return 32768 + 256 * s + (l - 8192); }
__device__ __forceinline__ void unpack8(const u32x4 v, float* f) { f[0] = bf_lo(v.x); f[1] = bf_hi(v.x); f[2] = bf_lo(v.y); f[3] = bf_hi(v.y); f[4] = bf_lo(v.z); f[5] = bf_hi(v.z); f[6] = bf_lo(v.w); f[7] = bf_hi(v.w); }
__device__ __forceinline__ u32x4 pack8(const float* f) { u32x4 w; w.x = cvt_pk_bf16(f[0], f[1]); w.y = cvt_pk_bf16(f[2], f[3]); w.z = cvt_pk_bf16(f[4], f[5]); w.w = cvt_pk_bf16(f[6], f[7]); return w; }

namespace pg8 {
constexpr int BM = 256, BK = 64, HALF = 128, HTB = HALF * BK * 2, STAGE_BYTES = 8 * HTB, NXCD = 8, WGM = 8;
__host__ __device__ __forceinline__ int lds_byte(int r, int c) { const int st = (r >> 4) * 2 + (c >> 5), rr = r & 15, cc = c & 31, ob = rr * 64 + cc * 2; return st * 1024 + (ob ^ (((ob >> 9) & 1) << 5)); }
__host__ __device__ __forceinline__ void stage_rc(int b, int& R, int& C) { const int st = b / 1024, sb = b % 1024, swz = sb ^ (((sb >> 9) & 1) << 5); R = (st >> 1) * 16 + swz / 64; C = (st & 1) * 32 + (swz % 64) / 2; }
__host__ __device__ __forceinline__ int perm32(int rho) { const int n = rho >> 4, i = rho & 15; return 8 * (i >> 2) + 4 * n + (i & 3); }
struct Unit { int pm, pn; };
struct Gemm { const bf16_t* A; const bf16_t* Bt; int M, N, K; };
struct StaticOrder {
    int nM, nN, nwg, G, c;
    __host__ __device__ void init(int M, int N, int G_, int c_) { nM = M / BM; nN = N / BM; nwg = nM * nN; G = G_; c = c_; }
    __host__ __device__ bool next(int i, Unit& u) const {
        const long L = (long)i * G + c; if (L >= nwg) return false;
        int wgid = (int)L; { const int q = nwg / NXCD, r = nwg % NXCD, xcd = wgid % NXCD, off = wgid / NXCD; wgid = (xcd < r ? xcd * (q + 1) : r * (q + 1) + (xcd - r) * q) + off; }
        const int nig = WGM * nN, gid = wgid / nig, fm = gid * WGM, gsz = (nM - fm) < WGM ? (nM - fm) : WGM;
        u.pm = fm + ((wgid % nig) % gsz); u.pn = (wgid % nig) / gsz; return true;
    }
    __device__ __forceinline__ void a_ready(const Unit&) const {}
    __device__ __forceinline__ void done(const Unit&) const {}
};

template <class Epi, class Sched>
__device__ __forceinline__ void gemm_phase(LAS unsigned char* lds, const Gemm g, const Sched& S, const Epi& E) {
    const int tid = opaque_tid(), wid = __builtin_amdgcn_readfirstlane(tid >> 6), lane = tid & 63, wr = wid >> 2, wc = wid & 3, fr = lane & 15, fq = lane >> 4;
    const int K = g.K, nt = K / BK;
    unsigned voffA[2], voffB[2];
#pragma unroll
    for (int i = 0; i < 2; ++i) { int R, C; stage_rc(tid * 16 + i * 8192, R, C); const int Rb = ((R & ~31) + perm32(R & 31));
        voffA[i] = (unsigned)(R * K + C) * 2u; voffB[i] = (unsigned)(Rb * K + C) * 2u; }
    const size_t kstep = (size_t)(BK * 2);
    const size_t hstep = (size_t)HALF * K * 2;
    const size_t tstep = 2 * hstep;
    const unsigned ldsw = (unsigned)wid * 1024u;
    const int aoff = lds_byte(wr * 64 + fr, fq * 8), boff = lds_byte(wc * 32 + fr, fq * 8);
#define PG8_SA(b, h) (((b) * 2 + (h)) * HTB)
#define PG8_SB(b, h) ((4 + (b) * 2 + (h)) * HTB)
#define PG8_STAGE(bufoff, gbase, voff) do { _Pragma("unroll") for (int _i = 0; _i < 2; ++_i) \
        __builtin_amdgcn_global_load_lds((const unsigned*)((const char*)(gbase) + (voff)[_i]), (LAS unsigned*)(lds + (bufoff) + ldsw + _i * 8192), 16, 0, 0); } while (0)
#define PG8_LDA(dst, b, h) do { _Pragma("unroll") for (int m = 0; m < 4; ++m) _Pragma("unroll") for (int k = 0; k < 2; ++k) dst[m][k] = *(const LAS bf16x8*)(lds + PG8_SA(b, h) + aoff + m * 2048 + k * 1024); } while (0)
#define PG8_LDB(dst, b, h) do { _Pragma("unroll") for (int n = 0; n < 2; ++n) _Pragma("unroll") for (int k = 0; k < 2; ++k) dst[n][k] = *(const LAS bf16x8*)(lds + PG8_SB(b, h) + boff + n * 2048 + k * 1024); } while (0)
#define PG8_MMA(ai, bj, At, Bt) do { __builtin_amdgcn_s_setprio(1); _Pragma("unroll") for (int m = 0; m < 4; ++m) _Pragma("unroll") for (int n = 0; n < 2; ++n) _Pragma("unroll") for (int k = 0; k < 2; ++k) \
        acc[ai][bj][m][n] = __builtin_amdgcn_mfma_f32_16x16x32_bf16(Bt[n][k], At[m][k], acc[ai][bj][m][n], 0, 0, 0); __builtin_amdgcn_s_setprio(0); } while (0)
#define PG8_WAIT_V(n) asm volatile("s_waitcnt vmcnt(" #n ")" ::: "memory")
#define PG8_WAIT_L(n) asm volatile("s_waitcnt lgkmcnt(" #n ")" ::: "memory")
#define PG8_BAR __builtin_amdgcn_s_barrier()
#define PG8_SCHED __builtin_amdgcn_sched_barrier(0)
    Unit cur, nxt; int ui = 0;
    if (!S.next(0, cur)) return;
    f32x4 acc[2][2][4][2];
#pragma unroll
    for (int a = 0; a < 2; ++a)
#pragma unroll
        for (int b = 0; b < 2; ++b)
#pragma unroll
            for (int m = 0; m < 4; ++m)
#pragma unroll
                for (int n = 0; n < 2; ++n) acc[a][b][m][n] = (f32x4){0.f, 0.f, 0.f, 0.f};
    bf16x8 At[4][2], B0[2][2], B1[2][2];
    const char* cA = (const char*)g.A + (size_t)cur.pm * tstep; const char* cB = (const char*)g.Bt + (size_t)cur.pn * tstep;
    S.a_ready(cur);
    PG8_STAGE(PG8_SB(0, 0), cB, voffB); PG8_STAGE(PG8_SA(0, 0), cA, voffA); PG8_STAGE(PG8_SB(0, 1), cB + hstep, voffB); PG8_STAGE(PG8_SA(0, 1), cA + hstep, voffA);
    if (wr == 1) PG8_BAR;
    PG8_WAIT_V(4); PG8_BAR;
    PG8_STAGE(PG8_SB(1, 0), cB + kstep, voffB); PG8_STAGE(PG8_SA(1, 0), cA + kstep, voffA); PG8_STAGE(PG8_SB(1, 1), cB + hstep + kstep, voffB);
    PG8_WAIT_V(6); PG8_BAR;
    for (;;) {
        const bool has_next = S.next(ui + 1, nxt);
        const char* nA = has_next ? (const char*)g.A + (size_t)nxt.pm * tstep : cA; const char* nB = has_next ? (const char*)g.Bt + (size_t)nxt.pn * tstep : cB;
#pragma unroll 1
        for (int t = 0; t < nt; t += 2) {
            const bool last = (t == nt - 2);
            const char* a1 = cA + (size_t)(t + 1) * kstep;
            const char* a2 = last ? nA : cA + (size_t)(t + 2) * kstep; const char* b2 = last ? nB : cB + (size_t)(t + 2) * kstep;
            const char* a3 = a2 + kstep; const char* b3 = b2 + kstep;
            if (last && has_next) S.a_ready(nxt);
            PG8_LDB(B0, 0, 0); PG8_SCHED; PG8_LDA(At, 0, 0); PG8_STAGE(PG8_SA(1, 1), a1 + hstep, voffA);
            PG8_WAIT_L(8); PG8_BAR; PG8_WAIT_L(0); PG8_MMA(0, 0, At, B0); PG8_BAR; PG8_SCHED;
            PG8_LDB(B1, 0, 1); PG8_STAGE(PG8_SB(0, 0), b2, voffB);
            PG8_BAR; PG8_WAIT_L(0); PG8_MMA(0, 1, At, B1); PG8_BAR;
            PG8_LDA(At, 0, 1); PG8_STAGE(PG8_SA(0, 0), a2, voffA);
            PG8_BAR; PG8_WAIT_L(0); PG8_MMA(1, 0, At, B0); PG8_BAR; PG8_SCHED;
            PG8_STAGE(PG8_SB(0, 1), b2 + hstep, voffB);
            PG8_WAIT_V(6); PG8_BAR; PG8_MMA(1, 1, At, B1); PG8_BAR;
            PG8_LDB(B0, 1, 0); PG8_SCHED; PG8_LDA(At, 1, 0); PG8_STAGE(PG8_SA(0, 1), a2 + hstep, voffA);
            PG8_WAIT_L(8); PG8_BAR; PG8_WAIT_L(0); PG8_MMA(0, 0, At, B0); PG8_BAR; PG8_SCHED;
            PG8_LDB(B1, 1, 1); PG8_STAGE(PG8_SB(1, 0), b3, voffB);
            PG8_BAR; PG8_WAIT_L(0); PG8_MMA(0, 1, At, B1); PG8_BAR;
            PG8_LDA(At, 1, 1); PG8_STAGE(PG8_SA(1, 0), a3, voffA);
            PG8_BAR; PG8_WAIT_L(0); PG8_MMA(1, 0, At, B0); PG8_BAR; PG8_SCHED;
            PG8_STAGE(PG8_SB(1, 1), b3 + hstep, voffB);
            PG8_WAIT_V(6); PG8_BAR; PG8_MMA(1, 1, At, B1); PG8_BAR;
        }
        E(acc, cur, wr, wc, fr, fq); S.done(cur);
        if (!has_next) break;
#pragma unroll
        for (int a = 0; a < 2; ++a)
#pragma unroll
            for (int b = 0; b < 2; ++b)
#pragma unroll
                for (int m = 0; m < 4; ++m)
#pragma unroll
                    for (int n = 0; n < 2; ++n) acc[a][b][m][n] = (f32x4){0.f, 0.f, 0.f, 0.f};
        cur = nxt; cA = nA; cB = nB; ++ui;
    }
    PG8_WAIT_V(0);
    if (wr == 0) PG8_BAR;
    PG8_BAR;
#undef PG8_SA
#undef PG8_SB
#undef PG8_STAGE
#undef PG8_LDA
#undef PG8_LDB
#undef PG8_MMA
#undef PG8_WAIT_V
#undef PG8_WAIT_L
#undef PG8_BAR
#undef PG8_SCHED
}
}

template <class F> struct EpiT {
    F f;
    __device__ __forceinline__ void operator()(const f32x4 (&acc)[2][2][4][2], const pg8::Unit& u, int wr, int wc, int fr, int fq) const {
        const int row0 = u.pm * 256 + wr * 64 + fr, col0 = u.pn * 256 + wc * 32 + 8 * fq;
        if constexpr (F::HAS_LOAD) {
            constexpr int PD = 4;
            typename F::LT buf[PD];
#pragma unroll
            for (int k = 0; k < PD; ++k) buf[k] = f.load(row0 + (k >> 3) * 128 + ((k >> 1) & 3) * 16, col0 + (k & 1) * 128);
#pragma unroll
            for (int idx = 0; idx < 16; ++idx) {
                const int ai = idx >> 3, m = (idx >> 1) & 3, bj = idx & 1;
                const typename F::LT cur = buf[idx % PD];
                if (idx + PD < 16) { const int i2 = idx + PD; buf[idx % PD] = f.load(row0 + (i2 >> 3) * 128 + ((i2 >> 1) & 3) * 16, col0 + (i2 & 1) * 128); }
                f.apply(row0 + ai * 128 + m * 16, col0 + bj * 128, acc[ai][bj][m][0], acc[ai][bj][m][1], cur); asm volatile("" ::: "memory");
            }
            return;
        }
#pragma unroll
        for (int ai = 0; ai < 2; ++ai)
#pragma unroll
            for (int m = 0; m < 4; ++m)
            {
                if constexpr (F::HAS_LOAD) { (void)ai; (void)m; break; }
                if constexpr (F::HAS_PAIR) { if (f.is_pair(u.pn)) { f.pair(row0 + ai * 128 + m * 16, col0, acc[ai][0][m][0], acc[ai][0][m][1], acc[ai][1][m][0], acc[ai][1][m][1]); asm volatile("" ::: "memory"); continue; } }
#pragma unroll
                for (int bj = 0; bj < 2; ++bj) { f(row0 + ai * 128 + m * 16, col0 + bj * 128, acc[ai][bj][m][0], acc[ai][bj][m][1]); asm volatile("" ::: "memory"); }
            }
    }
};
__device__ __forceinline__ u32x4 pack_v(const f32x4 v0, const f32x4 v1) { u32x4 w; w.x = cvt_pk_bf16(v0[0], v0[1]); w.y = cvt_pk_bf16(v0[2], v0[3]); w.z = cvt_pk_bf16(v1[0], v1[1]); w.w = cvt_pk_bf16(v1[2], v1[3]); return w; }

struct F1 {
    static constexpr bool HAS_LOAD = false;
    static constexpr bool HAS_PAIR = true;
    bf16_t* zq; bf16_t* za; bf16_t* zb4; bf16_t* gates; float* bd; int seg;
    __device__ __forceinline__ bool is_pair(int pn) const { return pn >= 16 && pn < 32; }
    __device__ __forceinline__ void pair(int row, int col, const f32x4 a0, const f32x4 a1, const f32x4 b0, const f32x4 b1) const {
        const int tt = (col - 4096) >> 8, ch = (tt & 7) * 128 + ((col - 4096) & 255); float o[8];
        if (tt < 8) {
#pragma unroll
            for (int j = 0; j < 4; ++j) { o[j] = a0[j] * b0[j]; o[4 + j] = a1[j] * b1[j]; }
            __builtin_nontemporal_store(pack8(o), (u32x4*)(zb4 + (size_t)row * 2048 + ch));
        } else {
#pragma unroll
            for (int j = 0; j < 4; ++j) { o[j] = a0[j] * siluf_(b0[j]); o[4 + j] = a1[j] * siluf_(b1[j]); }
            __builtin_nontemporal_store(pack8(o), (u32x4*)(zb4 + (size_t)row * 2048 + 1024 + ch));
        }
    }
    __device__ __forceinline__ void operator()(int row, int col, const f32x4 v0, const f32x4 v1) const {
        const size_t R = (size_t)seg * SEGM + row;
        if (col < 3072) __builtin_nontemporal_store(pack_v(v0, v1), (u32x4*)(zq + (size_t)row * 3072 + col));
        else if (col < 4096) __builtin_nontemporal_store(pack_v(v0, v1), (u32x4*)(za + R * 1024 + (col - 3072)));
        else if (col >= 8192 && col < 10240) __builtin_nontemporal_store(pack_v(v0, v1), (u32x4*)(gates + R * 2048 + (col - 8192)));
        else if (col >= 10240 && col < 10256) { float* d = bd + (size_t)row * 16 + (col - 10240); *(f32x4*)d = v0; *(f32x4*)(d + 4) = v1; }
    }
};
struct FB {
    static constexpr bool HAS_PAIR = false, HAS_LOAD = true;
    typedef u32x4 LT;
    bf16_t* mb; const bf16_t* gates;
    __device__ __forceinline__ LT load(int row, int col) const { return *(const u32x4*)(gates + (size_t)row * 2048 + 1024 + col); }
    __device__ __forceinline__ void apply(int row, int col, const f32x4 v0, const f32x4 v1, const LT& l) const {
        float gt[8]; unpack8(l, gt); float o[8];
#pragma unroll
        for (int j = 0; j < 4; ++j) { o[j] = sigmoidf_(gt[j]) * v0[j]; o[4 + j] = sigmoidf_(gt[4 + j]) * v1[j]; }
        __builtin_nontemporal_store(pack8(o), (u32x4*)(mb + (size_t)row * 1024 + col));
    }
    __device__ __forceinline__ void operator()(int, int, const f32x4, const f32x4) const {}
};
struct FA {
    static constexpr bool HAS_PAIR = false, HAS_LOAD = true;
    struct LT { u32x4 g, m; };
    bf16_t* mb; const bf16_t* gates;
    __device__ __forceinline__ LT load(int row, int col) const { LT l; l.g = *(const u32x4*)(gates + (size_t)row * 2048 + col); l.m = *(const u32x4*)(mb + (size_t)row * 1024 + col); return l; }
    __device__ __forceinline__ void apply(int row, int col, const f32x4 v0, const f32x4 v1, const LT& l) const {
        float gt[8], pm[8]; unpack8(l.g, gt); unpack8(l.m, pm); float o[8];
#pragma unroll
        for (int j = 0; j < 4; ++j) { o[j] = sigmoidf_(gt[j]) * v0[j] + pm[j]; o[4 + j] = sigmoidf_(gt[4 + j]) * v1[j] + pm[4 + j]; }
        __builtin_nontemporal_store(pack8(o), (u32x4*)(mb + (size_t)row * 1024 + col));
    }
    __device__ __forceinline__ void operator()(int, int, const f32x4, const f32x4) const {}
};
struct FO {
    static constexpr bool HAS_PAIR = false, HAS_LOAD = true;
    typedef u32x4 LT;
    bf16_t* pre; const bf16_t* hbf;
    __device__ __forceinline__ LT load(int row, int col) const { return *(const u32x4*)(hbf + (size_t)row * 1024 + col); }
    __device__ __forceinline__ void apply(int row, int col, const f32x4 v0, const f32x4 v1, const LT& l) const {
        float hv[8]; unpack8(l, hv); f32x4 a, b;
#pragma unroll
        for (int j = 0; j < 4; ++j) { a[j] = ALPHA_C * hv[j] + v0[j]; b[j] = ALPHA_C * hv[4 + j] + v1[j]; }
        __builtin_nontemporal_store(pack_v(a, b), (u32x4*)(pre + (size_t)row * 1024 + col));
    }
    __device__ __forceinline__ void operator()(int, int, const f32x4, const f32x4) const {}
};
struct FG {
    static constexpr bool HAS_LOAD = false;
    static constexpr bool HAS_PAIR = false;
    bf16_t* gb;
    __device__ __forceinline__ void operator()(int row, int col, const f32x4 v0, const f32x4 v1) const {
        float o[8];
#pragma unroll
        for (int j = 0; j < 4; ++j) { o[j] = sigmoidf_(v0[j]); o[4 + j] = sigmoidf_(v1[j]); }
        __builtin_nontemporal_store(pack8(o), (u32x4*)(gb + (size_t)row * 1024 + col));
    }
};
struct FP {
    static constexpr bool HAS_LOAD = false;
    static constexpr bool HAS_PAIR = false;
    float* out; const bf16_t* h1; const bf16_t* gb;
    __device__ __forceinline__ void operator()(int row, int col, const f32x4 v0, const f32x4 v1) const {
        float hv[8], gv[8]; unpack8(*(const u32x4*)(h1 + (size_t)row * 1024 + col), hv); unpack8(*(const u32x4*)(gb + (size_t)row * 1024 + col), gv); f32x4 a, b;
#pragma unroll
        for (int j = 0; j < 4; ++j) { a[j] = ALPHA_C * hv[j] + gv[j] * v0[j]; b[j] = ALPHA_C * hv[4 + j] + gv[4 + j] * v1[j]; }
        float* d = out + (size_t)row2tok(row) * 1024 + col; *(f32x4*)d = a; *(f32x4*)(d + 4) = b;
    }
};
struct FP2 {
    static constexpr bool HAS_LOAD = false;
    static constexpr bool HAS_PAIR = false;
    bf16_t* pb;
    __device__ __forceinline__ void operator()(int row, int col, const f32x4 v0, const f32x4 v1) const { __builtin_nontemporal_store(pack_v(v0, v1), (u32x4*)(pb + (size_t)row * 1024 + col)); }
};
struct FG2 {
    static constexpr bool HAS_PAIR = false, HAS_LOAD = true;
    struct LT { u32x4 h, pb; };
    bf16_t* out; const bf16_t* h1; const bf16_t* pb;
    __device__ __forceinline__ LT load(int row, int col) const { LT l; l.h = *(const u32x4*)(h1 + (size_t)row * 1024 + col); l.pb = *(const u32x4*)(pb + (size_t)row * 1024 + col); return l; }
    __device__ __forceinline__ void apply(int row, int col, const f32x4 v0, const f32x4 v1, const LT& l) const {
        float hv[8], pv[8]; unpack8(l.h, hv); unpack8(l.pb, pv); f32x4 a, b;
#pragma unroll
        for (int j = 0; j < 4; ++j) { a[j] = ALPHA_C * hv[j] + sigmoidf_(v0[j]) * pv[j]; b[j] = ALPHA_C * hv[4 + j] + sigmoidf_(v1[j]) * pv[4 + j]; }
        __builtin_nontemporal_store(pack_v(a, b), (u32x4*)(out + (size_t)row * 1024 + col));
    }
    __device__ __forceinline__ void operator()(int, int, const f32x4, const f32x4) const {}
};
template <class F> __device__ __forceinline__ void run_gemm(LAS unsigned char* lds, const bf16_t* A, const bf16_t* Bt, int M, int N, int K, const F& f, int skip = 0) {
    if ((int)blockIdx.x < skip) return;
    pg8::Gemm g{A, Bt, M, N, K}; pg8::StaticOrder S; S.init(M, N, (int)gridDim.x - skip, (int)blockIdx.x - skip); EpiT<F> E{f};
    pg8::gemm_phase<EpiT<F>, pg8::StaticOrder>(lds, g, S, E);
}

__device__ __forceinline__ void ln_row(const float* x, const float* gw, const float* bw, int lane, float (&o)[16]) {
    f32x4 v[4];
#pragma unroll
    for (int k = 0; k < 4; ++k) v[k] = *(const f32x4*)(x + 4 * lane + 256 * k);
    float s = 0.f;
#pragma unroll
    for (int k = 0; k < 4; ++k) s += (v[k][0] + v[k][1]) + (v[k][2] + v[k][3]);
    const float mu = wave_sum(s) * (1.0f / 1024.0f);
    float q = 0.f;
#pragma unroll
    for (int k = 0; k < 4; ++k) { const f32x4 d = v[k] - mu; q += (d[0] * d[0] + d[1] * d[1]) + (d[2] * d[2] + d[3] * d[3]); }
    const float rstd = rsqrtf(wave_sum(q) * (1.0f / 1024.0f) + 1e-5f);
#pragma unroll
    for (int k = 0; k < 4; ++k) { const f32x4 gg = *(const f32x4*)(gw + 4 * lane + 256 * k), bb = *(const f32x4*)(bw + 4 * lane + 256 * k);
#pragma unroll
        for (int j = 0; j < 4; ++j) o[4 * k + j] = (v[k][j] - mu) * rstd * gg[j] + bb[j]; }
}
__device__ __forceinline__ void ln_row_bf16in(const bf16_t* x, const float* gw, const float* bw, int lane, float (&o)[16]) {
    f32x4 v[4];
#pragma unroll
    for (int k = 0; k < 4; ++k) { const u32x2 u = *(const u32x2*)(x + 4 * lane + 256 * k); v[k] = (f32x4){bf_lo(u.x), bf_hi(u.x), bf_lo(u.y), bf_hi(u.y)}; }
    float s = 0.f;
#pragma unroll
    for (int k = 0; k < 4; ++k) s += (v[k][0] + v[k][1]) + (v[k][2] + v[k][3]);
    const float mu = wave_sum(s) * (1.0f / 1024.0f);
    float q = 0.f;
#pragma unroll
    for (int k = 0; k < 4; ++k) { const f32x4 d = v[k] - mu; q += (d[0] * d[0] + d[1] * d[1]) + (d[2] * d[2] + d[3] * d[3]); }
    const float rstd = rsqrtf(wave_sum(q) * (1.0f / 1024.0f) + 1e-5f);
#pragma unroll
    for (int k = 0; k < 4; ++k) { const f32x4 gg = *(const f32x4*)(gw + 4 * lane + 256 * k), bb = *(const f32x4*)(bw + 4 * lane + 256 * k);
#pragma unroll
        for (int j = 0; j < 4; ++j) o[4 * k + j] = (v[k][j] - mu) * rstd * gg[j] + bb[j]; }
}
__device__ __forceinline__ void store_row_bf16(bf16_t* dst, int lane, const float (&o)[16]) {
#pragma unroll
    for (int k = 0; k < 4; ++k) { u32x2 w; w.x = cvt_pk_bf16(o[4 * k], o[4 * k + 1]); w.y = cvt_pk_bf16(o[4 * k + 2], o[4 * k + 3]); *(u32x2*)(dst + 4 * lane + 256 * k) = w; }
}
__device__ __forceinline__ void cvtT(const float* src, int K, int Nsrc, bf16_t* dst, int Ndst, int mode, int gw, int nW, int lane) {
    const int nbn = Ndst / 64, nit = nbn * (K / 8);
    for (int it = gw; it < nit; it += nW) {
        const int nb = it % nbn, kb = it / nbn, n = nb * 64 + lane, k0 = kb * 8;
        int col = n;
        if (mode == 1) {
            if (n < 4096) col = n;
            else if (n < 8192) { const int tt = (n - 4096) >> 8, w = (n - 4096) & 255, hf = w >> 7, ch = (tt & 7) * 128 + (w & 127);
                col = tt < 8 ? (hf == 0 ? 5136 + ch : 6160 + ch) : (hf == 0 ? 4112 + ch : 7184 + ch); }
            else col = n < 10240 ? n + 16 : (n < 10256 ? 4096 + (n - 10240) : -1);
        }
        float f[8];
#pragma unroll
        for (int j = 0; j < 8; ++j) f[j] = col >= 0 ? src[(size_t)(k0 + j) * Nsrc + col] : 0.f;
        *(u32x4*)(dst + (size_t)n * K + k0) = pack8(f);
    }
}
__device__ void ln_in_rows(const Params& p, int r_lo, int r_hi, int gw, int nW, int lane) {
    bf16_t* hbf = (bf16_t*)(p.ws + W_HBF); bf16_t* pbf = (bf16_t*)(p.ws + W_PBF);
    for (int r = r_lo + gw; r < r_hi; r += nW) {
        const int t = row2tok(r);
        const float* x = t < 32768 ? p.in[0] + (size_t)t * 1024 : p.in[1] + (size_t)(t - 32768) * 1024;
        const float* pp = t < 32768 ? p.in[5] + (size_t)t * 256 : p.in[6] + (size_t)(t - 32768) * 256;
        float o[16]; ln_row(x, p.in[7], p.in[8], lane, o); store_row_bf16(hbf + (size_t)r * 1024, lane, o);
        const f32x4 pv = *(const f32x4*)(pp + 4 * lane); u32x2 w; w.x = cvt_pk_bf16(pv[0], pv[1]); w.y = cvt_pk_bf16(pv[2], pv[3]); *(u32x2*)(pbf + (size_t)r * 256 + 4 * lane) = w;
    }
}
__device__ void cvt_small_weights(const Params& p, int gw, int nW, int lane) {
    cvtT(p.in[15], 1024, 1024, (bf16_t*)(p.ws + W_WA), 1024, 0, gw, nW, lane);
    cvtT(p.in[16], 1024, 1024, (bf16_t*)(p.ws + W_WB), 1024, 0, gw, nW, lane);
    cvtT(p.in[17], 1024, 1024, (bf16_t*)(p.ws + W_WO), 1024, 0, gw, nW, lane);
    cvtT(p.in[21], 1024, 1024, (bf16_t*)(p.ws + W_WG), 1024, 0, gw, nW, lane);
    cvtT(p.in[20], 256, 1024, (bf16_t*)(p.ws + W_WP), 1024, 0, gw, nW, lane);
}
__device__ void phase0(const Params& p) {
    const int tid = opaque_tid(), lane = tid & 63, wid = tid >> 6, gw = blockIdx.x * 8 + wid, nW = gridDim.x * 8;
    ln_in_rows(p, 0, SEGM, gw, nW, lane);
    cvtT(p.in[9], 1024, 10256, (bf16_t*)(p.ws + W_WIN), NZ, 1, gw, nW, lane);
    float* ha = (float*)(p.ws + W_HISTA); float* hb = (float*)(p.ws + W_HISTB);
    for (int i = blockIdx.x * 512 + tid; i < 2 * 3 * 3072; i += gridDim.x * 512) ha[i] = 0.f;
    for (int i = blockIdx.x * 512 + tid; i < 2 * 2 * 1024; i += gridDim.x * 512) hb[i] = 0.f;
}

constexpr int P_KR = 0, P_QR = 17408, P_KT = 34816;
constexpr int H_VT = 0, H_AM = 18432, H_TU = 34816, H_TW = 44032, H_SC = 53248;
__device__ __forceinline__ bf16x8 fragR(LAS unsigned char* base, int row, int stride, int ks, int g) { return *(const LAS bf16x8*)(base + row * stride + (32 * ks + 8 * g) * 2); }
__device__ __forceinline__ float sel4(const f32x4 a, int i) { return i == 0 ? a[0] : (i == 1 ? a[1] : (i == 2 ? a[2] : a[3])); }

struct S1Regs { unsigned qpk[16], kpk[16], vT[2][8]; float be, gg; };
__device__ __forceinline__ void s1_compute(const Params& p, int seg, int item, int wq, int lane, S1Regs& R) {
    const int lc = item >> 3, h = item & 7;
    const bool prompt = lc < 128; const int b = lc >> 6, c = lc & 63;
    const int rowbase = prompt ? b * 4096 + c * 64 : 8192 + 32 * (lc - 128); const int nvalid = prompt ? 64 : 32;
    const bf16_t* zq = (const bf16_t*)(p.ws + W_ZQ);
    const float* hist = prompt ? (const float*)(p.ws + W_HISTA) + (size_t)(seg * 2 + b) * 9216 : p.in[2] + (size_t)(8 * seg + (lc - 128)) * 9216;
    const bool hist_from_z = prompt && c > 0;
    unsigned xr[3][19];
#pragma unroll
    for (int pt = 0; pt < 3; ++pt) {
        const int ch = pt * 1024 + h * 128 + 2 * lane;
#pragma unroll
        for (int jj = 0; jj < 19; ++jj) {
            const int tt = 16 * wq + jj - 3;
            if (tt >= 0 || hist_from_z) { const int ttc = tt < nvalid - 1 ? tt : nvalid - 1; xr[pt][jj] = *(const unsigned*)(zq + (size_t)(rowbase + ttc) * 3072 + ch); }
            else { const float* rp = hist + (size_t)(3 + tt) * 3072 + ch; xr[pt][jj] = cvt_pk_bf16(rp[0], rp[1]); }
        }
    }
#pragma unroll
    for (int pt = 0; pt < 3; ++pt) {
        const int ch = pt * 1024 + h * 128 + 2 * lane;
        float cw[4][2];
#pragma unroll
        for (int j = 0; j < 4; ++j) { cw[j][0] = p.in[10][j * 3072 + ch]; cw[j][1] = p.in[10][j * 3072 + ch + 1]; }
#pragma unroll
        for (int i2 = 0; i2 < 8; ++i2) {
            float y[2][2];
#pragma unroll
            for (int q = 0; q < 2; ++q) {
                const int i = 2 * i2 + q; const bool valid = (16 * wq + i) < nvalid;
                float a0 = bf_lo(xr[pt][i]) * cw[0][0], a1 = bf_hi(xr[pt][i]) * cw[0][1];
#pragma unroll
                for (int k = 1; k < 4; ++k) { a0 += bf_lo(xr[pt][i + k]) * cw[k][0]; a1 += bf_hi(xr[pt][i + k]) * cw[k][1]; }
                y[q][0] = valid ? siluf_(a0) : 0.f; y[q][1] = valid ? siluf_(a1) : 0.f;
            }
            if (pt == 0) { R.qpk[2 * i2] = cvt_pk_bf16(y[0][0], y[0][1]); R.qpk[2 * i2 + 1] = cvt_pk_bf16(y[1][0], y[1][1]); }
            else if (pt == 1) { R.kpk[2 * i2] = cvt_pk_bf16(y[0][0], y[0][1]); R.kpk[2 * i2 + 1] = cvt_pk_bf16(y[1][0], y[1][1]); }
            else { R.vT[0][i2] = cvt_pk_bf16(y[0][0], y[1][0]); R.vT[1][i2] = cvt_pk_bf16(y[0][1], y[1][1]); }
        }
    }
    if (wq == 0) {
        const float* bd = (const float*)(p.ws + W_BD);
        const int ic = lane < nvalid ? lane : nvalid - 1;
        const float bv = bd[(size_t)(rowbase + ic) * 16 + h], dv = bd[(size_t)(rowbase + ic) * 16 + 8 + h];
        const float xx = dv + p.in[12][h];
        const float sp = xx > 20.f ? xx : log1pf(__expf(xx));
        float gg = lane < nvalid ? -__expf(p.in[11][h]) * sp : 0.f;
        R.be = lane < nvalid ? sigmoidf_(bv) : 0.f;
#pragma unroll
        for (int d = 1; d < 64; d <<= 1) { const float t = __shfl_up(gg, d); if (lane >= d) gg += t; }
        R.gg = gg;
    }
}
__device__ __forceinline__ void s1_write(LAS unsigned char* lo, LAS unsigned char* hi, int wq, int lane, const S1Regs& R) {
#pragma unroll
    for (int i = 0; i < 16; ++i) { *(LAS unsigned*)(lo + P_QR + (16 * wq + i) * 272 + 4 * lane) = R.qpk[i]; *(LAS unsigned*)(lo + P_KR + (16 * wq + i) * 272 + 4 * lane) = R.kpk[i]; }
#pragma unroll
    for (int e = 0; e < 2; ++e)
#pragma unroll
        for (int hq = 0; hq < 2; ++hq) {
            u32x4 wk, wv;
#pragma unroll
            for (int j = 0; j < 4; ++j) { const unsigned a = R.kpk[8 * hq + 2 * j], b2 = R.kpk[8 * hq + 2 * j + 1];
                wk[j] = e == 0 ? ((a & 0xffffu) | (b2 << 16)) : ((a >> 16) | (b2 & 0xffff0000u)); wv[j] = R.vT[e][4 * hq + j]; }
            *(LAS u32x4*)(lo + P_KT + (2 * lane + e) * 144 + 32 * wq + 16 * hq) = wk;
            *(LAS u32x4*)(hi + H_VT + (2 * lane + e) * 144 + 32 * wq + 16 * hq) = wv;
        }
    if (wq == 0) { LAS float* SC = (LAS float*)(hi + H_SC); SC[lane] = R.be; SC[64 + lane] = R.gg; }
}
__device__ __forceinline__ void prep_item(const Params& p, int seg, int item, int next_item, S1Regs& R, LAS unsigned char* lds) {
    const int tid = opaque_tid(), lane = tid & 63, wid = __builtin_amdgcn_readfirstlane(tid >> 6), n = lane & 15, g = lane >> 4;
    const int lc = item >> 3, h = item & 7;
    unsigned char* ops = p.ws + W_OPS + (size_t)item * OPS_ITEM;
    LAS unsigned char* lo; LAS unsigned char* hi; { unsigned o0 = 0, o1 = 53248; asm volatile("" : "+v"(o0), "+v"(o1)); lo = lds + o0; hi = lds + o1; }
    LAS float* SC = (LAS float*)(hi + H_SC);
    if (wid >= 4) s1_write(lo, hi, wid - 4, lane, R);
    lds_barrier();
    const int it = wid >> 1, jh = wid & 1;
    f32x4 kka[2], qka[2];
    {
        bf16x8 ki[4], qi[4];
#pragma unroll
        for (int ks = 0; ks < 4; ++ks) { ki[ks] = fragR(lo + P_KR, 16 * it + n, 272, ks, g); qi[ks] = fragR(lo + P_QR, 16 * it + n, 272, ks, g); }
#pragma unroll
        for (int j2 = 0; j2 < 2; ++j2) {
            const int jt = 2 * jh + j2; f32x4 a = {0.f, 0.f, 0.f, 0.f}, q = {0.f, 0.f, 0.f, 0.f};
#pragma unroll
            for (int ks = 0; ks < 4; ++ks) { const bf16x8 kj = fragR(lo + P_KR, 16 * jt + n, 272, ks, g);
                a = __builtin_amdgcn_mfma_f32_16x16x32_bf16(ki[ks], kj, a, 0, 0, 0);
                q = __builtin_amdgcn_mfma_f32_16x16x32_bf16(kj, qi[ks], q, 0, 0, 0); }
            kka[j2] = a; qka[j2] = q;
        }
        f32x4 dg;
        const bool kdiag = (it >> 1) == jh;
        if (kdiag) dg = (it & 1) ? kka[1] : kka[0];
        else { dg = (f32x4){0.f, 0.f, 0.f, 0.f};
#pragma unroll
            for (int ks = 0; ks < 4; ++ks) dg = __builtin_amdgcn_mfma_f32_16x16x32_bf16(qi[ks], qi[ks], dg, 0, 0, 0); }
        const float dv = sel4(dg, n & 3);
        if (g == (n >> 2)) { if (kdiag) SC[192 + 16 * it + n] = rsqrtf(dv + 1e-6f); else SC[128 + 16 * it + n] = rsqrtf(dv + 1e-6f) * 0.08838834764831845f; }
    }
    lds_barrier();
    {
        bf16_t* qkg = (bf16_t*)(ops + 65536);
#pragma unroll
        for (int j2 = 0; j2 < 2; ++j2) {
            const int jt = 2 * jh + j2;
            { const int j = 16 * jt + n; const float rkj = SC[192 + j], gcj = SC[64 + j];
#pragma unroll
              for (int r = 0; r < 4; ++r) { const int i = 16 * it + 4 * g + r; const float df = SC[64 + i] - gcj;
                  const float v = (i > j) ? SC[i] * kka[j2][r] * SC[192 + i] * rkj * __expf(fminf(df, 0.f)) : 0.f;
                  *(LAS float*)(hi + H_AM + (i * 64 + j) * 4) = v; } }
            { const int i = 16 * it + n; const float rqi = SC[128 + i], gci = SC[64 + i]; float o[4];
#pragma unroll
              for (int r = 0; r < 4; ++r) { const int j = 16 * jt + 4 * g + r; const float df = gci - SC[64 + j];
                  o[r] = (i >= j) ? qka[j2][r] * rqi * SC[192 + j] * __expf(fminf(df, 0.f)) : 0.f; }
              u32x2 w; w.x = cvt_pk_bf16(o[0], o[1]); w.y = cvt_pk_bf16(o[2], o[3]);
              *(u32x2*)(qkg + i * 64 + 32 * (jt >> 1) + 8 * g + 4 * (jt & 1)) = w; }
        }
    }
    lds_barrier();
    if (wid < 4) {
        const LAS float* AM = (const LAS float*)(hi + H_AM);
        LAS float* TL; { unsigned o2 = 107520; asm volatile("" : "+v"(o2)); TL = (LAS float*)(lds + o2); }
        const int col = 16 * wid + n;
#pragma unroll 1
        for (int I = wid; I < 4; ++I) {
            float x[16];
            if (I > wid) {
                f32x4 acc = {0.f, 0.f, 0.f, 0.f};
#pragma unroll 1
                for (int J = wid; J < I; ++J) {
#pragma unroll
                    for (int ks = 0; ks < 4; ++ks)
                        acc = __builtin_amdgcn_mfma_f32_16x16x4f32(AM[(16 * I + n) * 64 + 16 * J + 4 * ks + g], TL[(16 * J + 4 * ks + g) * 64 + col], acc, 0, 0, 0);
                }
#pragma unroll
                for (int r = 0; r < 4; ++r) TL[(16 * I + 4 * g + r) * 64 + col] = -acc[r];
            }
#pragma unroll
            for (int r = 0; r < 16; ++r) { const float d = (16 * I + r) == col ? 1.f : 0.f; x[r] = I > wid ? TL[(16 * I + r) * 64 + col] + d : d; }
#pragma unroll
            for (int r = 1; r < 16; ++r) {
                f32x4 ar[4];
#pragma unroll
                for (int q = 0; q < (r + 3) / 4; ++q) ar[q] = *(const LAS f32x4*)(AM + (16 * I + r) * 64 + 16 * I + 4 * q);
                float s = x[r];
#pragma unroll
                for (int rp = 0; rp < r; ++rp) s -= ar[rp >> 2][rp & 3] * x[rp];
                x[r] = s;
            }
#pragma unroll
            for (int r = 0; r < 16; ++r) TL[(16 * I + r) * 64 + col] = x[r];
        }
        const float be = SC[col], sw = be * __expf(SC[64 + col]) * SC[192 + col];
        const bool zr = g < wid;
#pragma unroll 4
        for (int rr = 0; rr < 16; rr += 2) {
            const int i = 16 * g + rr;
            const float t0 = zr ? 0.f : TL[i * 64 + col], t1 = zr ? 0.f : TL[(i + 1) * 64 + col];
            const unsigned u = cvt_pk_bf16(t0 * be, t1 * be), w = cvt_pk_bf16(t0 * sw, t1 * sw);
            *(LAS bf16_t*)(hi + H_TU + i * 144 + 2 * col) = (bf16_t)(u & 0xffffu); *(LAS bf16_t*)(hi + H_TU + (i + 1) * 144 + 2 * col) = (bf16_t)(u >> 16);
            *(LAS bf16_t*)(hi + H_TW + i * 144 + 2 * col) = (bf16_t)(w & 0xffffu); *(LAS bf16_t*)(hi + H_TW + (i + 1) * 144 + 2 * col) = (bf16_t)(w >> 16);
        }
    } else {
        const float gcl = SC[64 + 63];
        for (int v = tid - 256; v < 2048; v += 256) {
            if (v < 1024) { const int i = v >> 4, c16 = v & 15; float f[8]; unpack8(*(const LAS u32x4*)(lo + P_QR + i * 272 + c16 * 16), f);
                const float s = SC[128 + i] * __expf(SC[64 + i]);
#pragma unroll
                for (int j = 0; j < 8; ++j) f[j] *= s;
                { const u32x4 pk = pack8(f); const int t = c16 >> 2, hf = (c16 >> 1) & 1, g1 = 2 * (c16 & 1);
                  bf16_t* dq = (bf16_t*)(ops + 16384) + i * 128 + 32 * t + 4 * hf;
                  *(u32x2*)(dq + 8 * g1) = (u32x2){pk.x, pk.y}; *(u32x2*)(dq + 8 * (g1 + 1)) = (u32x2){pk.z, pk.w}; }
            } else { const int vv = v - 1024, d = vv >> 3, c8 = vv & 7; float f[8]; unpack8(*(const LAS u32x4*)(lo + P_KT + d * 144 + c8 * 16), f);
#pragma unroll
                for (int j = 0; j < 8; ++j) { const int i = 8 * c8 + j; f[j] *= SC[192 + i] * __expf(gcl - SC[64 + i]); }
                { const u32x4 pk = pack8(f); const int t = c8 >> 2, hf = (c8 >> 1) & 1, g1 = 2 * (c8 & 1);
                  bf16_t* dk = (bf16_t*)(ops + 32768) + d * 64 + 32 * t + 4 * hf;
                  *(u32x2*)(dk + 8 * g1) = (u32x2){pk.x, pk.y}; *(u32x2*)(dk + 8 * (g1 + 1)) = (u32x2){pk.z, pk.w}; }
            }
        }
        if (tid == 256) ((float*)(p.ws + W_GL))[item] = __expf(gcl);
        if (next_item < 1088) s1_compute(p, seg, next_item, wid - 4, lane, R);
    }
    lds_barrier();
    {
        bf16x8 kt[2], vt[2];
#pragma unroll
        for (int ks = 0; ks < 2; ++ks) { kt[ks] = fragR(lo + P_KT, 16 * wid + n, 144, ks, g); vt[ks] = fragR(hi + H_VT, 16 * wid + n, 144, ks, g); }
        bf16_t* wg = (bf16_t*)ops; bf16_t* ug = (bf16_t*)(ops + 49152);
#pragma unroll
        for (int i4 = 0; i4 < 4; ++i4) {
            f32x4 wa = {0.f, 0.f, 0.f, 0.f}, ua = {0.f, 0.f, 0.f, 0.f};
#pragma unroll
            for (int ks = 0; ks < 2; ++ks) {
                wa = __builtin_amdgcn_mfma_f32_16x16x32_bf16(kt[ks], fragR(hi + (DBG_SKIP == 9 ? H_TU : H_TW), 16 * i4 + n, 144, ks, g), wa, 0, 0, 0);
                ua = __builtin_amdgcn_mfma_f32_16x16x32_bf16(fragR(hi + H_TU, 16 * i4 + n, 144, ks, g), vt[ks], ua, 0, 0, 0);
            }
            u32x2 w; w.x = cvt_pk_bf16(wa[0], wa[1]); w.y = cvt_pk_bf16(wa[2], wa[3]); *(u32x2*)(wg + (16 * i4 + n) * 128 + 32 * (wid >> 1) + 8 * g + 4 * (wid & 1)) = w;
            u32x2 u; u.x = cvt_pk_bf16(ua[0], ua[1]); u.y = cvt_pk_bf16(ua[2], ua[3]); *(u32x2*)(ug + (16 * wid + n) * 64 + 16 * i4 + 4 * g) = u;
        }
    }
    lds_barrier();
}

__device__ void yb_rows(const Params& p, int seg) {
    const int skipb = gridDim.x > 128 ? 64 : 0;
    if ((int)blockIdx.x < skipb) return;
    const int tid = opaque_tid(), lane = tid & 63, wid = tid >> 6, gw = ((int)blockIdx.x - skipb) * 8 + wid, nW = ((int)gridDim.x - skipb) * 8;
    const bf16_t* zb4 = (const bf16_t*)(p.ws + W_ZB4); const bf16_t* zq = (const bf16_t*)(p.ws + W_ZQ);
    bf16_t* yb = (bf16_t*)(p.ws + W_BUFB);
    for (int l = gw; l < SEGM; l += nW) {
        const size_t R = (size_t)seg * SEGM + l;
        const bool prompt = l < 8192; const int b = l >> 12, tl = prompt ? (l & 4095) : ((l - 8192) & 31), sq = 8 * seg + ((l - 8192) >> 5);
        const float* hb = prompt ? (const float*)(p.ws + W_HISTB) + (size_t)(seg * 2 + b) * 2048 : p.in[4] + (size_t)sq * 2048;
        const bf16_t* zr = zb4 + (size_t)l * 2048;
#pragma unroll
        for (int half = 0; half < 2; ++half) {
            const int c0 = 8 * lane + 512 * half;
            float cu[3][8];
#pragma unroll
            for (int k = 0; k < 3; ++k) {
                if (tl - k >= 0) { unpack8(*(const u32x4*)(zr - (size_t)k * 2048 + c0), cu[k]);
                } else { const float* hp = hb + (size_t)(2 + tl - k) * 1024 + c0;
#pragma unroll
                    for (int j = 0; j < 8; ++j) cu[k][j] = hp[j]; }
            }
            float bz[8], o[8]; unpack8(*(const u32x4*)(zr + 1024 + c0), bz);
#pragma unroll
            for (int j = 0; j < 8; ++j) { float cv = cu[2][j] * p.in[14][c0 + j]; cv += cu[1][j] * p.in[14][1024 + c0 + j]; cv += cu[0][j] * p.in[14][2048 + c0 + j]; o[j] = bz[j] * cv; }
            *(u32x4*)(yb + R * 1024 + c0) = pack8(o);
            if (prompt && tl >= 4094) { float* d = (float*)(p.ws + W_HISTB) + (size_t)((seg + 1) * 2 + b) * 2048 + (size_t)(tl - 4094) * 1024 + c0;
#pragma unroll
                for (int j = 0; j < 8; ++j) d[j] = cu[0][j];
                if (seg == NSEG - 1) { float* d2 = p.out + O_CBP + (size_t)b * 2048 + (size_t)(tl - 4094) * 1024 + c0;
#pragma unroll
                    for (int j = 0; j < 8; ++j) d2[j] = cu[0][j]; } }
            if (!prompt && tl >= 30) { float* d2 = p.out + O_CBS + (size_t)sq * 2048 + (size_t)(tl - 30) * 1024 + c0;
#pragma unroll
                for (int j = 0; j < 8; ++j) d2[j] = cu[0][j]; }
        }
        if ((prompt && tl >= 4093) || (!prompt && tl >= 29)) {
            const bf16_t* qr = zq + (size_t)l * 3072;
#pragma unroll
            for (int q = 0; q < 6; ++q) { const int c0 = 8 * lane + 512 * q; float f[8]; unpack8(*(const u32x4*)(qr + c0), f);
                if (prompt) { float* d = (float*)(p.ws + W_HISTA) + (size_t)((seg + 1) * 2 + b) * 9216 + (size_t)(tl - 4093) * 3072 + c0;
#pragma unroll
                    for (int j = 0; j < 8; ++j) d[j] = f[j];
                    if (seg == NSEG - 1) { float* d2 = p.out + O_CAP + (size_t)b * 9216 + (size_t)(tl - 4093) * 3072 + c0;
#pragma unroll
                        for (int j = 0; j < 8; ++j) d2[j] = f[j]; }
                } else { float* d2 = p.out + O_CAS + (size_t)sq * 9216 + (size_t)(tl - 29) * 3072 + c0;
#pragma unroll
                    for (int j = 0; j < 8; ++j) d2[j] = f[j]; }
            }
        }
    }
}
__device__ __forceinline__ void prep_phase(const Params& p, int seg, LAS unsigned char* lds) {
    S1Regs R;
    { const int tid0 = opaque_tid(), w0 = __builtin_amdgcn_readfirstlane(tid0 >> 6);
      if (w0 >= 4 && (int)blockIdx.x < 1088) s1_compute(p, seg, (int)blockIdx.x, w0 - 4, tid0 & 63, R); }
    for (int item = blockIdx.x; item < 1088; item += gridDim.x) prep_item(p, seg, item, item + (int)gridDim.x, R, lds);
    yb_rows(p, seg);
}

constexpr int S_W = 0, S_QD = 17408, S_KD = 34816, S_QK = 53248, S_BUF = 62464;
__device__ __forceinline__ bf16x8 fragP(LAS unsigned char* base, int row, int stride, int t, int g) {
    return *(const LAS bf16x8*)(base + row * stride + (32 * t + 8 * g) * 2);
}
__device__ __forceinline__ bf16x8 pack_frag(const f32x4 a, const f32x4 b) { u32x4 v; v.x = cvt_pk_bf16(a[0], a[1]); v.y = cvt_pk_bf16(a[2], a[3]); v.z = cvt_pk_bf16(b[0], b[1]); v.w = cvt_pk_bf16(b[2], b[3]); return __builtin_bit_cast(bf16x8, v); }

__device__ void scan_phase(const Params& p, int seg, LAS unsigned char* lds, bool dry = false, unsigned* done_ctr = nullptr) {
    const int tid = opaque_tid(), lane = tid & 63, wid = __builtin_amdgcn_readfirstlane(tid >> 6), n = lane & 15, g = lane >> 4;
    bf16_t* oseg = (bf16_t*)(p.ws + W_OSEG);
    const float* glb = (const float*)(p.ws + W_GL);
    for (int it = blockIdx.x; it < 80; it += gridDim.x) {
        if (DBG_SKIP >= 3 && it < 16) continue;
        const bool prompt = it < 16;
        const int b = it >> 3, h = it & 7, sj = (it - 16) >> 3, nsteps = prompt ? 64 : 1, nvalid = prompt ? 64 : 32;
        const float* sin; float* sout;
        if (prompt) { sout = p.out + O_SP + (size_t)(b * 8 + h) * 16384; sin = seg > 0 ? sout : nullptr; }
        else { const int sq = 8 * seg + sj; sin = p.in[3] + (size_t)(sq * 8 + h) * 16384; sout = p.out + O_SS + (size_t)(sq * 8 + h) * 16384; }
        f32x4 S[8];
#pragma unroll
        for (int t = 0; t < 8; ++t)
#pragma unroll
            for (int r = 0; r < 4; ++r) S[t][r] = sin ? sin[(size_t)(16 * t + 4 * g + r) * 128 + 16 * wid + n] : 0.f;
        const int item0 = (prompt ? b * 64 : 128 + sj) * 8 + h;
        const int rowbase0 = prompt ? b * 4096 : 8192 + 32 * sj;
        u32x4 st[1][7]; u32x2 un[1][4]; float gln[1];
#define SCAN_ISSUE(c_, k_) do { const unsigned char* ob = p.ws + W_OPS + (size_t)(item0 + 8 * (c_)) * OPS_ITEM; \
            _Pragma("unroll") for (int q = 0; q < 7; ++q) { const int v = tid + 512 * q; const size_t so = (q < 4 ? (size_t)v * 16 : (q < 6 ? 32768 + (size_t)(v - 2048) * 16 : 65536 + (size_t)(v - 3072) * 16)); st[k_][q] = *(const u32x4*)(ob + so); } \
            _Pragma("unroll") for (int mt = 0; mt < 4; ++mt) un[k_][mt] = *(const u32x2*)(ob + 49152 + (size_t)((16 * wid + n) * 64 + 16 * mt + 4 * g) * 2); \
            gln[k_] = glb[item0 + 8 * (c_)]; } while (0)
#define SCAN_COMMIT(buf_, k_) do { LAS unsigned char* cb = lds + (buf_) * S_BUF; \
            _Pragma("unroll") for (int q = 0; q < 7; ++q) { const int v = tid + 512 * q; int off; \
                if (q < 2) off = S_W + (v >> 4) * 272 + (v & 15) * 16; \
                else if (q < 4) off = S_QD + ((v - 1024) >> 4) * 272 + (v & 15) * 16; \
                else if (q < 6) off = S_KD + ((v - 2048) >> 3) * 144 + (v & 7) * 16; \
                else off = S_QK + ((v - 3072) >> 3) * 144 + (v & 7) * 16; \
                *(LAS u32x4*)(cb + off) = st[k_][q]; } \
            _Pragma("unroll") for (int mt = 0; mt < 4; ++mt) uc[mt] = un[k_][mt]; \
            gl = gln[k_]; } while (0)
        u32x2 uc[4]; float gl;
        auto compute = [&](int c) {
            LAS unsigned char* bb = lds + (c & 1) * S_BUF;
            bf16x8 Sb[4];
#pragma unroll
            for (int t = 0; t < 4; ++t) Sb[t] = pack_frag(S[2 * t], S[2 * t + 1]);
            bf16x8 F[2][4]; f32x4 vn[4], ao[4];
#define LD_RW(P, off, mt) do { _Pragma("unroll") for (int t = 0; t < 4; ++t) F[P][t] = fragP(bb + (off), 16 * (mt) + n, 272, t, g); } while (0)
#define LD_PR(P, off, r0) do { F[P][0] = fragP(bb + (off), 16 * (r0) + n, 144, 0, g); F[P][1] = fragP(bb + (off), 16 * (r0) + n, 144, 1, g); \
                               F[P][2] = fragP(bb + (off), 16 * ((r0) + 1) + n, 144, 0, g); F[P][3] = fragP(bb + (off), 16 * ((r0) + 1) + n, 144, 1, g); } while (0)
#define SBAR __builtin_amdgcn_sched_barrier(0)
#define VN_STEP(P, mt) do { f32x4 a = {0.f, 0.f, 0.f, 0.f}; _Pragma("unroll") for (int t = 0; t < 4; ++t) a = __builtin_amdgcn_mfma_f32_16x16x32_bf16(F[P][t], Sb[t], a, 0, 0, 0); \
            vn[mt][0] = bf_lo(uc[mt].x) - a[0]; vn[mt][1] = bf_hi(uc[mt].x) - a[1]; vn[mt][2] = bf_lo(uc[mt].y) - a[2]; vn[mt][3] = bf_hi(uc[mt].y) - a[3]; } while (0)
#define QD_STEP(P, mt) do { f32x4 a = {0.f, 0.f, 0.f, 0.f}; _Pragma("unroll") for (int t = 0; t < 4; ++t) a = __builtin_amdgcn_mfma_f32_16x16x32_bf16(Sb[t], F[P][t], a, 0, 0, 0); ao[mt] = a; } while (0)
#define O_STORE(mt) do { if (16 * (mt) + n < nvalid) { u32x2 w; w.x = cvt_pk_bf16(ao[mt][0], ao[mt][1]); w.y = cvt_pk_bf16(ao[mt][2], ao[mt][3]); \
            *(u32x2*)(oseg + (size_t)(rowb + 16 * (mt) + n) * 1024 + h * 128 + 16 * wid + 4 * g) = w; } } while (0)
#define QK_STEP(P, q) do { ao[2 * (q)] = __builtin_amdgcn_mfma_f32_16x16x32_bf16(vb[0], F[P][0], ao[2 * (q)], 0, 0, 0); ao[2 * (q)] = __builtin_amdgcn_mfma_f32_16x16x32_bf16(vb[1], F[P][1], ao[2 * (q)], 0, 0, 0); \
            ao[2 * (q) + 1] = __builtin_amdgcn_mfma_f32_16x16x32_bf16(vb[0], F[P][2], ao[2 * (q) + 1], 0, 0, 0); ao[2 * (q) + 1] = __builtin_amdgcn_mfma_f32_16x16x32_bf16(vb[1], F[P][3], ao[2 * (q) + 1], 0, 0, 0); \
            O_STORE(2 * (q)); O_STORE(2 * (q) + 1); } while (0)
#define KD_STEP(P, k) do { f32x4 a0 = S[2 * (k)] * gl, a1 = S[2 * (k) + 1] * gl; \
            a0 = __builtin_amdgcn_mfma_f32_16x16x32_bf16(F[P][0], vb[0], a0, 0, 0, 0); a1 = __builtin_amdgcn_mfma_f32_16x16x32_bf16(F[P][2], vb[0], a1, 0, 0, 0); \
            a0 = __builtin_amdgcn_mfma_f32_16x16x32_bf16(F[P][1], vb[1], a0, 0, 0, 0); a1 = __builtin_amdgcn_mfma_f32_16x16x32_bf16(F[P][3], vb[1], a1, 0, 0, 0); S[2 * (k)] = a0; S[2 * (k) + 1] = a1; } while (0)
            const int rowb = rowbase0 + 64 * c;
            LD_RW(0, S_W, 0); SBAR;
            LD_RW(1, S_W, 1); SBAR; VN_STEP(0, 0); SBAR;
            LD_RW(0, S_W, 2); SBAR; VN_STEP(1, 1); SBAR;
            LD_RW(1, S_W, 3); SBAR; VN_STEP(0, 2); SBAR;
            LD_RW(0, S_QD, 0); SBAR; VN_STEP(1, 3); SBAR;
            bf16x8 vb[2]; vb[0] = pack_frag(vn[0], vn[1]); vb[1] = pack_frag(vn[2], vn[3]);
            LD_RW(1, S_QD, 1); SBAR; QD_STEP(0, 0); SBAR;
            LD_RW(0, S_QD, 2); SBAR; QD_STEP(1, 1); SBAR;
            LD_RW(1, S_QD, 3); SBAR; QD_STEP(0, 2); SBAR;
            LD_PR(0, S_QK, 0); SBAR; QD_STEP(1, 3); SBAR;
            LD_PR(1, S_QK, 2); SBAR; QK_STEP(0, 0); SBAR;
            LD_PR(0, S_KD, 0); SBAR; QK_STEP(1, 1); SBAR;
            LD_PR(1, S_KD, 2); SBAR; KD_STEP(0, 0); SBAR;
            LD_PR(0, S_KD, 4); SBAR; KD_STEP(1, 1); SBAR;
            LD_PR(1, S_KD, 6); SBAR; KD_STEP(0, 2); SBAR;
            KD_STEP(1, 3); SBAR;
#undef LD_RW
#undef LD_PR
#undef SBAR
#undef VN_STEP
#undef QD_STEP
#undef O_STORE
#undef QK_STEP
#undef KD_STEP
        };
        SCAN_ISSUE(0, 0); SCAN_COMMIT(0, 0);
        lds_barrier();
        for (int c = 0; c < nsteps; ++c) {
            if (c + 1 < nsteps) SCAN_ISSUE(c + 1, 0);
            compute(c);
            if (c + 1 < nsteps) SCAN_COMMIT((c + 1) & 1, 0);
            lds_barrier();
        }
#undef SCAN_ISSUE
#undef SCAN_COMMIT
#pragma unroll
        for (int t = 0; t < 8; ++t)
#pragma unroll
            for (int r = 0; r < 4; ++r) { if (!dry) sout[(size_t)(16 * t + 4 * g + r) * 128 + 16 * wid + n] = S[t][r]; }
        if (done_ctr) {
            asm volatile("s_waitcnt vmcnt(0)" ::: "memory"); __syncthreads();
            if (threadIdx.x == 0) { __builtin_amdgcn_fence(__ATOMIC_RELEASE, "agent"); asm volatile("s_waitcnt vmcnt(0)" ::: "memory");
                (void)__hip_atomic_fetch_add(done_ctr, 1u, __ATOMIC_RELAXED, __HIP_MEMORY_SCOPE_AGENT); }
        }
    }
}

__device__ void ya_phase(const Params& p, int seg, int skipb = 0) {
    if ((int)blockIdx.x < skipb) return;
    const int tid = opaque_tid(), lane = tid & 63, wid = tid >> 6, gw = ((int)blockIdx.x - skipb) * 8 + wid, nW = ((int)gridDim.x - skipb) * 8;
    const bf16_t* oseg = (const bf16_t*)(p.ws + W_OSEG); bf16_t* za = (bf16_t*)(p.ws + W_BUFA);
    for (int l = gw; l < SEGM; l += nW) {
        const size_t R = (size_t)seg * SEGM + l; const int c0 = 16 * lane;
        float o[16], z[16];
        unpack8(*(const u32x4*)(oseg + (size_t)l * 1024 + c0), o); unpack8(*(const u32x4*)(oseg + (size_t)l * 1024 + c0 + 8), o + 8);
        unpack8(*(const u32x4*)(za + R * 1024 + c0), z); unpack8(*(const u32x4*)(za + R * 1024 + c0 + 8), z + 8);
        float ss = 0.f;
#pragma unroll
        for (int j = 0; j < 16; ++j) ss += o[j] * o[j];
        ss += __shfl_xor(ss, 1); ss += __shfl_xor(ss, 2); ss += __shfl_xor(ss, 4);
        const float rs = rsqrtf(ss * (1.0f / 128.0f) + 1e-6f);
        float y[16];
#pragma unroll
        for (int j = 0; j < 16; ++j) y[j] = o[j] * rs * p.in[13][(c0 + j) & 127] * siluf_(z[j]);
        *(u32x4*)(za + R * 1024 + c0) = pack8(y); *(u32x4*)(za + R * 1024 + c0 + 8) = pack8(y + 8);
    }
}
__device__ void ln1_phase(const Params& p) {
    const int tid = opaque_tid(), lane = tid & 63, wid = tid >> 6, gw = blockIdx.x * 8 + wid, nW = gridDim.x * 8;
    bf16_t* h1 = (bf16_t*)(p.ws + W_BUFA);
    for (int r = gw; r < MROWS; r += nW) { float o[16]; ln_row_bf16in((const bf16_t*)p.out + (size_t)r * 1024, p.in[18], p.in[19], lane, o); store_row_bf16(h1 + (size_t)r * 1024, lane, o); }
}
__device__ void ln2_phase(const Params& p) {
    const int tid = opaque_tid(), lane = tid & 63, wid = tid >> 6, gw = blockIdx.x * 8 + wid, nW = gridDim.x * 8;
    for (int r = gw; r < MROWS; r += nW) { float o[16]; float* x = p.out + (size_t)row2tok(r) * 1024; ln_row_bf16in((const bf16_t*)(p.ws + W_BUFB) + (size_t)r * 1024, p.in[22], p.in[23], lane, o);
#pragma unroll
        for (int k = 0; k < 4; ++k) *(f32x4*)(x + 4 * lane + 256 * k) = (f32x4){o[4 * k], o[4 * k + 1], o[4 * k + 2], o[4 * k + 3]}; }
}

#define XB_TMO      128
#define XB_XCNT(j)  (256  + 64 * (j))
#define XB_XSUB(j)  (1280 + 64 * (j))
#define XB_XGEN(j)  (2304 + 64 * (j))
#define XB_TOP      3328
#define XB_TOPGEN   3392
#define XCD_BAR_WORDS 3456
#define XB_SPIN_CAP (1u << 20)
__device__ __forceinline__ unsigned xb_ld(unsigned* p)              { return __hip_atomic_load(p, __ATOMIC_RELAXED, __HIP_MEMORY_SCOPE_AGENT); }
__device__ __forceinline__ unsigned xb_add(unsigned* p, unsigned v) { return __hip_atomic_fetch_add(p, v, __ATOMIC_RELAXED, __HIP_MEMORY_SCOPE_AGENT); }
__device__ __forceinline__ unsigned xb_xcc_id() { return (unsigned)__builtin_amdgcn_s_getreg((3 << 11) | 20) & 0xFu; }
#define XB_SPIN(cond, bar) do { unsigned _sp = 0; while (cond) { __builtin_amdgcn_s_sleep(1); \
    if ((++_sp & 255u) == 0u) { if (xb_ld(&(bar)[XB_TMO])) break; if (_sp > XB_SPIN_CAP) { atomicAdd(&(bar)[XB_TMO], 1u); break; } } } } while (0)
struct XcdBarrier { unsigned* bar; unsigned x; volatile LAS unsigned* st; };
__device__ __forceinline__ XcdBarrier xcd_barrier_post(unsigned* bar, volatile LAS unsigned* st) {
    XcdBarrier b; b.bar = bar; b.x = xb_xcc_id(); b.st = st;
    if (threadIdx.x == 0) (void)xb_add(&bar[XB_XCNT(b.x)], 1u);
    return b;
}
__device__ __forceinline__ void xcd_barrier_complete(unsigned* bar, unsigned x, unsigned& nloc, unsigned& nx) {
    const unsigned G = gridDim.x * gridDim.y * gridDim.z;
    unsigned sum, cnt, mine, sp = 0u;
    for (;;) {
        sum = 0u; cnt = 0u; mine = 0u;
#pragma unroll
        for (unsigned j = 0; j < 16; ++j) { const unsigned c = xb_ld(&bar[XB_XCNT(j)]); sum += c; cnt += (c > 0u) ? 1u : 0u; mine = (j == x) ? c : mine; }
        if (sum == G) break;
        __builtin_amdgcn_s_sleep(1);
        if ((++sp & 255u) == 0u) { if (xb_ld(&bar[XB_TMO])) break; if (sp > XB_SPIN_CAP) { atomicAdd(&bar[XB_TMO], 1u); break; } }
    }
    nloc = mine > 0u ? mine : 1u; nx = cnt > 0u ? cnt : 1u;
}
__device__ __forceinline__ void xcd_barrier(const XcdBarrier& b) {
    asm volatile("s_waitcnt vmcnt(0)" ::: "memory");
    __syncthreads();
    if (threadIdx.x == 0) {
        unsigned* bar = b.bar;
        __builtin_amdgcn_s_waitcnt(0);
        unsigned nloc = b.st[0], nx = b.st[1];
        if (nloc == 0u) { xcd_barrier_complete(bar, b.x, nloc, nx); b.st[0] = nloc; b.st[1] = nx; }
        const unsigned old = xb_add(&bar[XB_XSUB(b.x)], 1u);
        const unsigned gen = old / nloc;
        if (old + 1u == (gen + 1u) * nloc) {
            __builtin_amdgcn_fence(__ATOMIC_RELEASE, "agent");
            asm volatile("s_waitcnt vmcnt(0)" ::: "memory");
            const unsigned og = xb_add(&bar[XB_TOP], 1u);
            const unsigned tg = og / nx;
            if (og + 1u == (tg + 1u) * nx) xb_add(&bar[XB_TOPGEN], 1u);
            else XB_SPIN(xb_ld(&bar[XB_TOPGEN]) == tg, bar);
            __builtin_amdgcn_fence(__ATOMIC_ACQUIRE, "agent");
            xb_add(&bar[XB_XGEN(b.x)], 1u);
            asm volatile("s_waitcnt vmcnt(0)" ::: "memory");
        } else {
            XB_SPIN(xb_ld(&bar[XB_XGEN(b.x)]) == gen, bar);
            __builtin_amdgcn_fence(__ATOMIC_ACQUIRE, "agent");
            asm volatile("s_waitcnt vmcnt(0)" ::: "memory");
        }
    }
    __syncthreads();
}

__global__ void __launch_bounds__(512, 2) mk_fwd(Params p) {
    extern __shared__ __attribute__((aligned(16))) unsigned char shm[];
    LAS unsigned char* lds = (LAS unsigned char*)shm;
    cg::grid_group grid = cg::this_grid();
    unsigned char* ws = p.ws;
    volatile LAS unsigned* stw = (volatile LAS unsigned*)(lds + 131072);
    if (threadIdx.x == 0) { stw[0] = 0u; stw[1] = 0u; }
    __syncthreads();
    const XcdBarrier xb = xcd_barrier_post((unsigned*)(ws + W_BAR), stw);
    for (int ph = p.ph_lo; ph < p.ph_hi; ++ph) {
      for (int rep = 0; rep < (ph == REP_PH ? REP_N : 1); ++rep) {
        if (rep > 0) grid.sync();
        if (ph == 0) phase0(p);
        else if (ph == 1 || (ph >= 3 && ph <= 7 && (ph & 1))) {
            const int seg = ph == 1 ? 0 : ((ph - 3) >> 1) + 1, skip = ph == 1 ? 0 : 16;
            if (REP_PH == 103 && ph == 3) scan_phase(p, seg - 1, lds, true);
            if (ph != 1 && rep == 0) scan_phase(p, seg - 1, lds);
            F1 f{(bf16_t*)(ws + W_ZQ), (bf16_t*)(ws + W_BUFA), (bf16_t*)(ws + W_ZB4), (bf16_t*)p.out, (float*)(ws + W_BD), seg};
            run_gemm(lds, (const bf16_t*)(ws + W_HBF) + (size_t)seg * SEGM * 1024, (const bf16_t*)(ws + W_WIN), SEGM, NZ, 1024, f, skip);
            if (ph == 1) {
                const int G = (int)gridDim.x, rem = ((SEGM / 256) * (NZ / 256)) % G, first = rem;
                if ((int)blockIdx.x >= first) { const int t2 = opaque_tid(); ln_in_rows(p, SEGM, MROWS, ((int)blockIdx.x - first) * 8 + (t2 >> 6), (G - first) * 8, t2 & 63);
                    cvt_small_weights(p, ((int)blockIdx.x - first) * 8 + (t2 >> 6), (G - first) * 8, t2 & 63); }
            }
        }
        else if (ph >= 2 && ph <= 8) { const int seg = (ph - 2) >> 1; prep_phase(p, seg, lds); if (seg > 0) ya_phase(p, seg - 1, gridDim.x > 128 ? 64 : 0); }
        else if (ph == 9) { unsigned* ctr = (unsigned*)(ws + W_BAR) + 64;
            scan_phase(p, 3, lds, false, ctr);
            FB f{(bf16_t*)(ws + W_ZB4), (const bf16_t*)p.out}; run_gemm(lds, (const bf16_t*)(ws + W_BUFB), (const bf16_t*)(ws + W_WB), MROWS, 1024, 1024, f, 16);
            if ((int)blockIdx.x >= 64) {
                if (threadIdx.x == 0) { unsigned sp = 0; while (__hip_atomic_load(ctr, __ATOMIC_RELAXED, __HIP_MEMORY_SCOPE_AGENT) < 80u) { __builtin_amdgcn_s_sleep(4); if (++sp > (1u << 24)) break; }
                    __builtin_amdgcn_fence(__ATOMIC_ACQUIRE, "agent"); asm volatile("s_waitcnt vmcnt(0)" ::: "memory"); }
                __syncthreads();
                ya_phase(p, 3, 64);
            } }
        else if (ph == 10) { FA f{(bf16_t*)(ws + W_ZB4), (const bf16_t*)p.out}; run_gemm(lds, (const bf16_t*)(ws + W_BUFA), (const bf16_t*)(ws + W_WA), MROWS, 1024, 1024, f); }
        else if (ph == 11) { FO f{(bf16_t*)p.out, (const bf16_t*)(ws + W_HBF)}; run_gemm(lds, (const bf16_t*)(ws + W_ZB4), (const bf16_t*)(ws + W_WO), MROWS, 1024, 1024, f);
            FP2 f2{(bf16_t*)(ws + W_OPS)}; run_gemm(lds, (const bf16_t*)(ws + W_PBF), (const bf16_t*)(ws + W_WP), MROWS, 1024, 256, f2, 16); }
        else if (ph == 12) ln1_phase(p);
        else if (ph == 13) { FG2 f{(bf16_t*)(ws + W_BUFB), (const bf16_t*)(ws + W_BUFA), (const bf16_t*)(ws + W_OPS)}; run_gemm(lds, (const bf16_t*)(ws + W_BUFA), (const bf16_t*)(ws + W_WG), MROWS, 1024, 1024, f); }
        else ln2_phase(p);
      }
        if (ph + 1 < p.ph_hi) { if (p.ph_hi > NPH) grid.sync(); else xcd_barrier(xb); }
        if (REP_PH == 100 && ph == 10) { for (int q = 0; q < 20; ++q) grid.sync(); }
    }
    if (DBG_SKIP && p.ph_hi == NPH) {
        const size_t i0 = (size_t)blockIdx.x * 512 + threadIdx.x, st = (size_t)gridDim.x * 512;
        for (size_t i = i0; i < O_CAP; i += st) p.out[i] = 0.f;
        if (DBG_SKIP == 1) { for (size_t i = i0; i < 262144; i += st) p.out[O_SP + i] = 0.f; for (size_t i = i0; i < 4194304; i += st) p.out[O_SS + i] = 0.f; }
        if (DBG_SKIP >= 3) { for (size_t i = i0; i < 262144; i += st) p.out[O_SP + i] = 0.f; }
    }
}

extern "C" void kernel_launch(void* const* d_in, const int* in_sizes, int n_in, void* d_out, int out_size, void* d_ws, size_t ws_size, hipStream_t stream) {
    static int grid = 0;
    if (grid == 0) {
        if (n_in != 24 || out_size != 39442432 || ws_size < W_END) { fprintf(stderr, "kernel_launch: unexpected shapes (n_in %d out %d ws %zu need %zu)\n", n_in, out_size, ws_size, (size_t)W_END); grid = -1; return; }
        int dev = 0, cus = 0, per_cu = 0;
        hipGetDevice(&dev); hipDeviceGetAttribute(&cus, hipDeviceAttributeMultiprocessorCount, dev);
        if (hipFuncSetAttribute((const void*)mk_fwd, hipFuncAttributeMaxDynamicSharedMemorySize, LDS_BYTES) != hipSuccess) { fprintf(stderr, "hipFuncSetAttribute failed\n"); grid = -1; return; }
        if (hipOccupancyMaxActiveBlocksPerMultiprocessor(&per_cu, (const void*)mk_fwd, 512, LDS_BYTES) != hipSuccess || per_cu < 1) { fprintf(stderr, "occupancy query failed (%d)\n", per_cu); grid = -1; return; }
        grid = cus * 1;
        fprintf(stderr, "kernel_launch: grid %d (per_cu %d), ws need %zu have %zu\n", grid, per_cu, (size_t)W_END, ws_size);
    }
    if (grid < 0) return;
    if (hipMemsetAsync((char*)d_ws + W_BAR, 0, 16384, stream) != hipSuccess) { fprintf(stderr, "kernel_launch: memset of barrier words failed\n"); return; }
    Params p{};
    for (int i = 0; i < 24; ++i) p.in[i] = (const float*)d_in[i];
    p.out = (float*)d_out; p.ws = (unsigned char*)d_ws;
#if MK_MULTI
    for (int ph = 0; ph < NPH; ++ph) { p.ph_lo = ph; p.ph_hi = ph + 1; hipLaunchKernelGGL(mk_fwd, dim3(grid), dim3(512), LDS_BYTES, stream, p); }
#else
    p.ph_lo = 0; p.ph_hi = NPH;
    void* args[] = {&p};
    hipError_t e = hipLaunchCooperativeKernel((void*)mk_fwd, dim3(grid), dim3(512), args, LDS_BYTES, stream);
    if (e != hipSuccess) fprintf(stderr, "cooperative launch failed: %s (grid %d)\n", hipGetErrorString(e), grid);
#endif
}
```

```cpp
#include <hip/hip_runtime.h>
#include <hip/hip_cooperative_groups.h>
#include <cstdio>
namespace cg = cooperative_groups;

#ifndef DBG_SKIP
#define DBG_SKIP 0
#endif
#ifndef REP_PH
#define REP_PH -1
#endif
#ifndef REP_N
#define REP_N 1
#endif
#ifndef MK_MULTI
#define MK_MULTI 0
#endif

#define LAS __attribute__((address_space(3)))
typedef unsigned short bf16_t;
typedef short bf16x8 __attribute__((ext_vector_type(8)));
typedef float f32x4 __attribute__((ext_vector_type(4)));
typedef unsigned u32x4 __attribute__((ext_vector_type(4)));
typedef unsigned u32x2 __attribute__((ext_vector_type(2)));

constexpr int MROWS = 33792, SEGM = 8448, NSEG = 4, DM = 1024, NZ = 10496, PD = 256;
constexpr float ALPHA_C = 1.189207115002721f;
constexpr int NPH = 15;
constexpr int LDS_BYTES = 131072 + 16;
constexpr size_t O_Y = 0, O_CAP = 34603008, O_SP = 34621440, O_CBP = 34883584, O_CAS = 34887680, O_SS = 35182592, O_CBS = 39376896;
constexpr size_t W_WIN = 0;
constexpr size_t W_WA = W_WIN + (size_t)NZ * 1024 * 2;
constexpr size_t W_WB = W_WA + 2097152, W_WO = W_WB + 2097152, W_WG = W_WO + 2097152;
constexpr size_t W_WP = W_WG + 2097152;
constexpr size_t W_PBF = W_WP + 524288;
constexpr size_t W_HBF = W_PBF + (size_t)MROWS * 256 * 2;
constexpr size_t W_BUFA = W_HBF + (size_t)MROWS * 2048;
constexpr size_t W_BUFB = W_BUFA + (size_t)MROWS * 2048;
constexpr size_t W_ZQ = W_BUFB + (size_t)MROWS * 2048;
constexpr size_t W_ZB4 = W_ZQ + (size_t)SEGM * 3072 * 2;
constexpr size_t W_BD = W_ZB4 + (size_t)SEGM * 4096 * 2;
constexpr size_t W_OPS = W_BD + (size_t)SEGM * 64;
constexpr size_t OPS_ITEM = 73728;
constexpr size_t W_GL = W_OPS + 1088 * OPS_ITEM;
constexpr size_t W_OSEG = W_GL + 8192;
constexpr size_t W_HISTA = W_OSEG + (size_t)SEGM * 2048;
constexpr size_t W_HISTB = W_HISTA + 5 * 2 * 3 * 3072 * 4;
constexpr size_t W_BAR = W_HISTB + 5 * 2 * 2 * 1024 * 4;
constexpr size_t W_END = W_BAR + 16384;

struct Params { const float* in[24]; float* out; unsigned char* ws; int ph_lo, ph_hi; };

typedef __bf16 bf16x2_t __attribute__((ext_vector_type(2)));
typedef float f32x2_t __attribute__((ext_vector_type(2)));
__device__ __forceinline__ unsigned cvt_pk_bf16(float lo, float hi) { f32x2_t v = {lo, hi}; bf16x2_t b = __builtin_convertvector(v, bf16x2_t); return __builtin_bit_cast(unsigned, b); }
__device__ __forceinline__ float bf_lo(unsigned u) { return __uint_as_float(u << 16); }
__device__ __forceinline__ float bf_hi(unsigned u) { return __uint_as_float(u & 0xffff0000u); }
__device__ __forceinline__ float sigmoidf_(float x) { return __builtin_amdgcn_rcpf(1.0f + __expf(-x)); }
__device__ __forceinline__ float siluf_(float x) { return x * __builtin_amdgcn_rcpf(1.0f + __expf(-x)); }
__device__ __forceinline__ int opaque_tid() { int t = threadIdx.x; asm volatile("" : "+v"(t)); return t; }
__device__ __forceinline__ void lds_barrier() { asm volatile("s_waitcnt lgkmcnt(0)" ::: "memory"); __builtin_amdgcn_s_barrier(); asm volatile("" ::: "memory"); }
__device__ __forceinline__ float wave_sum(float v) {
#pragma unroll
    for (int m = 32; m >= 1; m >>= 1) v += __shfl_xor(v, m);
    return v;
}
__device__ __forceinline__ int row2tok(int r) { const int s = r / SEGM, l = r - s * SEGM; if (l < 4096) return 4096 * s + l; if (l < 8192) return 16384 + 4096 * s + (l - 4096); return 32768 + 256 * s + (l - 8192); }
__device__ __forceinline__ void unpack8(const u32x4 v, float* f) { f[0] = bf_lo(v.x); f[1] = bf_hi(v.x); f[2] = bf_lo(v.y); f[3] = bf_hi(v.y); f[4] = bf_lo(v.z); f[5] = bf_hi(v.z); f[6] = bf_lo(v.w); f[7] = bf_hi(v.w); }
__device__ __forceinline__ u32x4 pack8(const float* f) { u32x4 w; w.x = cvt_pk_bf16(f[0], f[1]); w.y = cvt_pk_bf16(f[2], f[3]); w.z = cvt_pk_bf16(f[4], f[5]); w.w = cvt_pk_bf16(f[6], f[7]); return w; }

namespace pg8 {
constexpr int BM = 256, BK = 64, HALF = 128, HTB = HALF * BK * 2, STAGE_BYTES = 8 * HTB, NXCD = 8, WGM = 8;
__host__ __device__ __forceinline__ int lds_byte(int r, int c) { const int st = (r >> 4) * 2 + (c >> 5), rr = r & 15, cc = c & 31, ob = rr * 64 + cc * 2; return st * 1024 + (ob ^ (((ob >> 9) & 1) << 5)); }
__host__ __device__ __forceinline__ void stage_rc(int b, int& R, int& C) { const int st = b / 1024, sb = b % 1024, swz = sb ^ (((sb >> 9) & 1) << 5); R = (st >> 1) * 16 + swz / 64; C = (st & 1) * 32 + (swz % 64) / 2; }
__host__ __device__ __forceinline__ int perm32(int rho) { const int n = rho >> 4, i = rho & 15; return 8 * (i >> 2) + 4 * n + (i & 3); }
struct Unit { int pm, pn; };
struct Gemm { const bf16_t* A; const bf16_t* Bt; int M, N, K; };
struct StaticOrder {
    int nM, nN, nwg, G, c;
    __host__ __device__ void init(int M, int N, int G_, int c_) { nM = M / BM; nN = N / BM; nwg = nM * nN; G = G_; c = c_; }
    __host__ __device__ bool next(int i, Unit& u) const {
        const long L = (long)i * G + c; if (L >= nwg) return false;
        int wgid = (int)L; { const int q = nwg / NXCD, r = nwg % NXCD, xcd = wgid % NXCD, off = wgid / NXCD; wgid = (xcd < r ? xcd * (q + 1) : r * (q + 1) + (xcd - r) * q) + off; }
        const int nig = WGM * nN, gid = wgid / nig, fm = gid * WGM, gsz = (nM - fm) < WGM ? (nM - fm) : WGM;
        u.pm = fm + ((wgid % nig) % gsz); u.pn = (wgid % nig) / gsz; return true;
    }
    __device__ __forceinline__ void a_ready(const Unit&) const {}
    __device__ __forceinline__ void done(const Unit&) const {}
};

template <class Epi, class Sched>
__device__ __forceinline__ void gemm_phase(LAS unsigned char* lds, const Gemm g, const Sched& S, const Epi& E) {
    const int tid = opaque_tid(), wid = __builtin_amdgcn_readfirstlane(tid >> 6), lane = tid & 63, wr = wid >> 2, wc = wid & 3, fr = lane & 15, fq = lane >> 4;
    const int K = g.K, nt = K / BK;
    unsigned voffA[2], voffB[2];
#pragma unroll
    for (int i = 0; i < 2; ++i) { int R, C; stage_rc(tid * 16 + i * 8192, R, C); const int Rb = ((R & ~31) + perm32(R & 31));
        voffA[i] = (unsigned)(R * K + C) * 2u; voffB[i] = (unsigned)(Rb * K + C) * 2u; }
    const size_t kstep = (size_t)(BK * 2);
    const size_t hstep = (size_t)HALF * K * 2;
    const size_t tstep = 2 * hstep;
    const unsigned ldsw = (unsigned)wid * 1024u;
    const int aoff = lds_byte(wr * 64 + fr, fq * 8), boff = lds_byte(wc * 32 + fr, fq * 8);
#define PG8_SA(b, h) (((b) * 2 + (h)) * HTB)
#define PG8_SB(b, h) ((4 + (b) * 2 + (h)) * HTB)
#define PG8_STAGE(bufoff, gbase, voff) do { _Pragma("unroll") for (int _i = 0; _i < 2; ++_i) \
        __builtin_amdgcn_global_load_lds((const unsigned*)((const char*)(gbase) + (voff)[_i]), (LAS unsigned*)(lds + (bufoff) + ldsw + _i * 8192), 16, 0, 0); } while (0)
#define PG8_LDA(dst, b, h) do { _Pragma("unroll") for (int m = 0; m < 4; ++m) _Pragma("unroll") for (int k = 0; k < 2; ++k) dst[m][k] = *(const LAS bf16x8*)(lds + PG8_SA(b, h) + aoff + m * 2048 + k * 1024); } while (0)
#define PG8_LDB(dst, b, h) do { _Pragma("unroll") for (int n = 0; n < 2; ++n) _Pragma("unroll") for (int k = 0; k < 2; ++k) dst[n][k] = *(const LAS bf16x8*)(lds + PG8_SB(b, h) + boff + n * 2048 + k * 1024); } while (0)
#define PG8_MMA(ai, bj, At, Bt) do { __builtin_amdgcn_s_setprio(1); _Pragma("unroll") for (int m = 0; m < 4; ++m) _Pragma("unroll") for (int n = 0; n < 2; ++n) _Pragma("unroll") for (int k = 0; k < 2; ++k) \
        acc[ai][bj][m][n] = __builtin_amdgcn_mfma_f32_16x16x32_bf16(Bt[n][k], At[m][k], acc[ai][bj][m][n], 0, 0, 0); __builtin_amdgcn_s_setprio(0); } while (0)
#define PG8_WAIT_V(n) asm volatile("s_waitcnt vmcnt(" #n ")" ::: "memory")
#define PG8_WAIT_L(n) asm volatile("s_waitcnt lgkmcnt(" #n ")" ::: "memory")
#define PG8_BAR __builtin_amdgcn_s_barrier()
#define PG8_SCHED __builtin_amdgcn_sched_barrier(0)
    Unit cur, nxt; int ui = 0;
    if (!S.next(0, cur)) return;
    f32x4 acc[2][2][4][2];
#pragma unroll
    for (int a = 0; a < 2; ++a)
#pragma unroll
        for (int b = 0; b < 2; ++b)
#pragma unroll
            for (int m = 0; m < 4; ++m)
#pragma unroll
                for (int n = 0; n < 2; ++n) acc[a][b][m][n] = (f32x4){0.f, 0.f, 0.f, 0.f};
    bf16x8 At[4][2], B0[2][2], B1[2][2];
    const char* cA = (const char*)g.A + (size_t)cur.pm * tstep; const char* cB = (const char*)g.Bt + (size_t)cur.pn * tstep;
    S.a_ready(cur);
    PG8_STAGE(PG8_SB(0, 0), cB, voffB); PG8_STAGE(PG8_SA(0, 0), cA, voffA); PG8_STAGE(PG8_SB(0, 1), cB + hstep, voffB); PG8_STAGE(PG8_SA(0, 1), cA + hstep, voffA);
    if (wr == 1) PG8_BAR;
    PG8_WAIT_V(4); PG8_BAR;
    PG8_STAGE(PG8_SB(1, 0), cB + kstep, voffB); PG8_STAGE(PG8_SA(1, 0), cA + kstep, voffA); PG8_STAGE(PG8_SB(1, 1), cB + hstep + kstep, voffB);
    PG8_WAIT_V(6); PG8_BAR;
    for (;;) {
        const bool has_next = S.next(ui + 1, nxt);
        const char* nA = has_next ? (const char*)g.A + (size_t)nxt.pm * tstep : cA; const char* nB = has_next ? (const char*)g.Bt + (size_t)nxt.pn * tstep : cB;
#pragma unroll 1
        for (int t = 0; t < nt; t += 2) {
            const bool last = (t == nt - 2);
            const char* a1 = cA + (size_t)(t + 1) * kstep;
            const char* a2 = last ? nA : cA + (size_t)(t + 2) * kstep; const char* b2 = last ? nB : cB + (size_t)(t + 2) * kstep;
            const char* a3 = a2 + kstep; const char* b3 = b2 + kstep;
            if (last && has_next) S.a_ready(nxt);
            PG8_LDB(B0, 0, 0); PG8_SCHED; PG8_LDA(At, 0, 0); PG8_STAGE(PG8_SA(1, 1), a1 + hstep, voffA);
            PG8_WAIT_L(8); PG8_BAR; PG8_WAIT_L(0); PG8_MMA(0, 0, At, B0); PG8_BAR; PG8_SCHED;
            PG8_LDB(B1, 0, 1); PG8_STAGE(PG8_SB(0, 0), b2, voffB);
            PG8_BAR; PG8_WAIT_L(0); PG8_MMA(0, 1, At, B1); PG8_BAR;
            PG8_LDA(At, 0, 1); PG8_STAGE(PG8_SA(0, 0), a2, voffA);
            PG8_BAR; PG8_WAIT_L(0); PG8_MMA(1, 0, At, B0); PG8_BAR; PG8_SCHED;
            PG8_STAGE(PG8_SB(0, 1), b2 + hstep, voffB);
            PG8_WAIT_V(6); PG8_BAR; PG8_MMA(1, 1, At, B1); PG8_BAR;
            PG8_LDB(B0, 1, 0); PG8_SCHED; PG8_LDA(At, 1, 0); PG8_STAGE(PG8_SA(0, 1), a2 + hstep, voffA);
            PG8_WAIT_L(8); PG8_BAR; PG8_WAIT_L(0); PG8_MMA(0, 0, At, B0); PG8_BAR; PG8_SCHED;
            PG8_LDB(B1, 1, 1); PG8_STAGE(PG8_SB(1, 0), b3, voffB);
            PG8_BAR; PG8_WAIT_L(0); PG8_MMA(0, 1, At, B1); PG8_BAR;
            PG8_LDA(At, 1, 1); PG8_STAGE(PG8_SA(1, 0), a3, voffA);
            PG8_BAR; PG8_WAIT_L(0); PG8_MMA(1, 0, At, B0); PG8_BAR; PG8_SCHED;
            PG8_STAGE(PG8_SB(1, 1), b3 + hstep, voffB);
            PG8_WAIT_V(6); PG8_BAR; PG8_MMA(1, 1, At, B1); PG8_BAR;
        }
        E(acc, cur, wr, wc, fr, fq); S.done(cur);
        if (!has_next) break;
#pragma unroll
        for (int a = 0; a < 2; ++a)
#pragma unroll
            for (int b = 0; b < 2; ++b)
#pragma unroll
                for (int m = 0; m < 4; ++m)
#pragma unroll
                    for (int n = 0; n < 2; ++n) acc[a][b][m][n] = (f32x4){0.f, 0.f, 0.f, 0.f};
        cur = nxt; cA = nA; cB = nB; ++ui;
    }
    PG8_WAIT_V(0);
    if (wr == 0) PG8_BAR;
    PG8_BAR;
#undef PG8_SA
#undef PG8_SB
#undef PG8_STAGE
#undef PG8_LDA
#undef PG8_LDB
#undef PG8_MMA
#undef PG8_WAIT_V
#undef PG8_WAIT_L
#undef PG8_BAR
#undef PG8_SCHED
}
}

template <class F> struct EpiT {
    F f;
    __device__ __forceinline__ void operator()(const f32x4 (&acc)[2][2][4][2], const pg8::Unit& u, int wr, int wc, int fr, int fq) const {
        const int row0 = u.pm * 256 + wr * 64 + fr, col0 = u.pn * 256 + wc * 32 + 8 * fq;
        if constexpr (F::HAS_LOAD) {
            constexpr int PD = 4;
            typename F::LT buf[PD];
#pragma unroll
            for (int k = 0; k < PD; ++k) buf[k] = f.load(row0 + (k >> 3) * 128 + ((k >> 1) & 3) * 16, col0 + (k & 1) * 128);
#pragma unroll
            for (int idx = 0; idx < 16; ++idx) {
                const int ai = idx >> 3, m = (idx >> 1) & 3, bj = idx & 1;
                const typename F::LT cur = buf[idx % PD];
                if (idx + PD < 16) { const int i2 = idx + PD; buf[idx % PD] = f.load(row0 + (i2 >> 3) * 128 + ((i2 >> 1) & 3) * 16, col0 + (i2 & 1) * 128); }
                f.apply(row0 + ai * 128 + m * 16, col0 + bj * 128, acc[ai][bj][m][0], acc[ai][bj][m][1], cur); asm volatile("" ::: "memory");
            }
            return;
        }
#pragma unroll
        for (int ai = 0; ai < 2; ++ai)
#pragma unroll
            for (int m = 0; m < 4; ++m)
            {
                if constexpr (F::HAS_LOAD) { (void)ai; (void)m; break; }
                if constexpr (F::HAS_PAIR) { if (f.is_pair(u.pn)) { f.pair(row0 + ai * 128 + m * 16, col0, acc[ai][0][m][0], acc[ai][0][m][1], acc[ai][1][m][0], acc[ai][1][m][1]); asm volatile("" ::: "memory"); continue; } }
#pragma unroll
                for (int bj = 0; bj < 2; ++bj) { f(row0 + ai * 128 + m * 16, col0 + bj * 128, acc[ai][bj][m][0], acc[ai][bj][m][1]); asm volatile("" ::: "memory"); }
            }
    }
};
__device__ __forceinline__ u32x4 pack_v(const f32x4 v0, const f32x4 v1) { u32x4 w; w.x = cvt_pk_bf16(v0[0], v0[1]); w.y = cvt_pk_bf16(v0[2], v0[3]); w.z = cvt_pk_bf16(v1[0], v1[1]); w.w = cvt_pk_bf16(v1[2], v1[3]); return w; }

struct F1 {
    static constexpr bool HAS_LOAD = false;
    static constexpr bool HAS_PAIR = true;
    bf16_t* zq; bf16_t* za; bf16_t* zb4; bf16_t* gates; float* bd; int seg;
    __device__ __forceinline__ bool is_pair(int pn) const { return pn >= 16 && pn < 32; }
    __device__ __forceinline__ void pair(int row, int col, const f32x4 a0, const f32x4 a1, const f32x4 b0, const f32x4 b1) const {
        const int tt = (col - 4096) >> 8, ch = (tt & 7) * 128 + ((col - 4096) & 255); float o[8];
        if (tt < 8) {
#pragma unroll
            for (int j = 0; j < 4; ++j) { o[j] = a0[j] * b0[j]; o[4 + j] = a1[j] * b1[j]; }
            __builtin_nontemporal_store(pack8(o), (u32x4*)(zb4 + (size_t)row * 2048 + ch));
        } else {
#pragma unroll
            for (int j = 0; j < 4; ++j) { o[j] = a0[j] * siluf_(b0[j]); o[4 + j] = a1[j] * siluf_(b1[j]); }
            __builtin_nontemporal_store(pack8(o), (u32x4*)(zb4 + (size_t)row * 2048 + 1024 + ch));
        }
    }
    __device__ __forceinline__ void operator()(int row, int col, const f32x4 v0, const f32x4 v1) const {
        const size_t R = (size_t)seg * SEGM + row;
        if (col < 3072) __builtin_nontemporal_store(pack_v(v0, v1), (u32x4*)(zq + (size_t)row * 3072 + col));
        else if (col < 4096) __builtin_nontemporal_store(pack_v(v0, v1), (u32x4*)(za + R * 1024 + (col - 3072)));
        else if (col >= 8192 && col < 10240) __builtin_nontemporal_store(pack_v(v0, v1), (u32x4*)(gates + R * 2048 + (col - 8192)));
        else if (col >= 10240 && col < 10256) { float* d = bd + (size_t)row * 16 + (col - 10240); *(f32x4*)d = v0; *(f32x4*)(d + 4) = v1; }
    }
};
struct FB {
    static constexpr bool HAS_PAIR = false, HAS_LOAD = true;
    typedef u32x4 LT;
    bf16_t* mb; const bf16_t* gates;
    __device__ __forceinline__ LT load(int row, int col) const { return __builtin_nontemporal_load((const u32x4*)(gates + (size_t)row * 2048 + 1024 + col)); }
    __device__ __forceinline__ void apply(int row, int col, const f32x4 v0, const f32x4 v1, const LT& l) const {
        float gt[8]; unpack8(l, gt); float o[8];
#pragma unroll
        for (int j = 0; j < 4; ++j) { o[j] = sigmoidf_(gt[j]) * v0[j]; o[4 + j] = sigmoidf_(gt[4 + j]) * v1[j]; }
        *(u32x4*)(mb + (size_t)row * 1024 + col) = pack8(o);
    }
    __device__ __forceinline__ void operator()(int, int, const f32x4, const f32x4) const {}
};
struct FA {
    static constexpr bool HAS_PAIR = false, HAS_LOAD = true;
    struct LT { u32x4 g, m; };
    bf16_t* mb; const bf16_t* gates;
    __device__ __forceinline__ LT load(int row, int col) const { LT l; l.g = __builtin_nontemporal_load((const u32x4*)(gates + (size_t)row * 2048 + col)); l.m = __builtin_nontemporal_load((const u32x4*)(mb + (size_t)row * 1024 + col)); return l; }
    __device__ __forceinline__ void apply(int row, int col, const f32x4 v0, const f32x4 v1, const LT& l) const {
        float gt[8], pm[8]; unpack8(l.g, gt); unpack8(l.m, pm); float o[8];
#pragma unroll
        for (int j = 0; j < 4; ++j) { o[j] = sigmoidf_(gt[j]) * v0[j] + pm[j]; o[4 + j] = sigmoidf_(gt[4 + j]) * v1[j] + pm[4 + j]; }
        *(u32x4*)(mb + (size_t)row * 1024 + col) = pack8(o);
    }
    __device__ __forceinline__ void operator()(int, int, const f32x4, const f32x4) const {}
};
struct FO {
    static constexpr bool HAS_PAIR = false, HAS_LOAD = true;
    typedef u32x4 LT;
    bf16_t* pre; const bf16_t* hbf;
    __device__ __forceinline__ LT load(int row, int col) const { return __builtin_nontemporal_load((const u32x4*)(hbf + (size_t)row * 1024 + col)); }
    __device__ __forceinline__ void apply(int row, int col, const f32x4 v0, const f32x4 v1, const LT& l) const {
        float hv[8]; unpack8(l, hv); f32x4 a, b;
#pragma unroll
        for (int j = 0; j < 4; ++j) { a[j] = ALPHA_C * hv[j] + v0[j]; b[j] = ALPHA_C * hv[4 + j] + v1[j]; }
        *(u32x4*)(pre + (size_t)row * 1024 + col) = pack_v(a, b);
    }
    __device__ __forceinline__ void operator()(int, int, const f32x4, const f32x4) const {}
};
struct FG {
    static constexpr bool HAS_LOAD = false;
    static constexpr bool HAS_PAIR = false;
    bf16_t* gb;
    __device__ __forceinline__ void operator()(int row, int col, const f32x4 v0, const f32x4 v1) const {
        float o[8];
#pragma unroll
        for (int j = 0; j < 4; ++j) { o[j] = sigmoidf_(v0[j]); o[4 + j] = sigmoidf_(v1[j]); }
        *(u32x4*)(gb + (size_t)row * 1024 + col) = pack8(o);
    }
};
struct FP {
    static constexpr bool HAS_LOAD = false;
    static constexpr bool HAS_PAIR = false;
    float* out; const bf16_t* h1; const bf16_t* gb;
    __device__ __forceinline__ void operator()(int row, int col, const f32x4 v0, const f32x4 v1) const {
        float hv[8], gv[8]; unpack8(*(const u32x4*)(h1 + (size_t)row * 1024 + col), hv); unpack8(*(const u32x4*)(gb + (size_t)row * 1024 + col), gv); f32x4 a, b;
#pragma unroll
        for (int j = 0; j < 4; ++j) { a[j] = ALPHA_C * hv[j] + gv[j] * v0[j]; b[j] = ALPHA_C * hv[4 + j] + gv[4 + j] * v1[j]; }
        float* d = out + (size_t)row2tok(row) * 1024 + col; *(f32x4*)d = a; *(f32x4*)(d + 4) = b;
    }
};
struct FP2 {
    static constexpr bool HAS_LOAD = false;
    static constexpr bool HAS_PAIR = false;
    bf16_t* pb;
    __device__ __forceinline__ void operator()(int row, int col, const f32x4 v0, const f32x4 v1) const { *(u32x4*)(pb + (size_t)row * 1024 + col) = pack_v(v0, v1); }
};
struct FG2 {
    static constexpr bool HAS_PAIR = false, HAS_LOAD = true;
    struct LT { u32x4 h, pb; };
    bf16_t* out; const bf16_t* h1; const bf16_t* pb;
    __device__ __forceinline__ LT load(int row, int col) const { LT l; l.h = __builtin_nontemporal_load((const u32x4*)(h1 + (size_t)row * 1024 + col)); l.pb = __builtin_nontemporal_load((const u32x4*)(pb + (size_t)row * 1024 + col)); return l; }
    __device__ __forceinline__ void apply(int row, int col, const f32x4 v0, const f32x4 v1, const LT& l) const {
        float hv[8], pv[8]; unpack8(l.h, hv); unpack8(l.pb, pv); f32x4 a, b;
#pragma unroll
        for (int j = 0; j < 4; ++j) { a[j] = ALPHA_C * hv[j] + sigmoidf_(v0[j]) * pv[j]; b[j] = ALPHA_C * hv[4 + j] + sigmoidf_(v1[j]) * pv[4 + j]; }
        *(u32x4*)(out + (size_t)row * 1024 + col) = pack_v(a, b);
    }
    __device__ __forceinline__ void operator()(int, int, const f32x4, const f32x4) const {}
};
template <class F> __device__ __forceinline__ void run_gemm(LAS unsigned char* lds, const bf16_t* A, const bf16_t* Bt, int M, int N, int K, const F& f, int skip = 0) {
    if ((int)blockIdx.x < skip) return;
    pg8::Gemm g{A, Bt, M, N, K}; pg8::StaticOrder S; S.init(M, N, (int)gridDim.x - skip, (int)blockIdx.x - skip); EpiT<F> E{f};
    pg8::gemm_phase<EpiT<F>, pg8::StaticOrder>(lds, g, S, E);
}

__device__ __forceinline__ void ln_row(const float* x, const float* gw, const float* bw, int lane, float (&o)[16]) {
    f32x4 v[4];
#pragma unroll
    for (int k = 0; k < 4; ++k) v[k] = *(const f32x4*)(x + 4 * lane + 256 * k);
    float s = 0.f;
#pragma unroll
    for (int k = 0; k < 4; ++k) s += (v[k][0] + v[k][1]) + (v[k][2] + v[k][3]);
    const float mu = wave_sum(s) * (1.0f / 1024.0f);
    float q = 0.f;
#pragma unroll
    for (int k = 0; k < 4; ++k) { const f32x4 d = v[k] - mu; q += (d[0] * d[0] + d[1] * d[1]) + (d[2] * d[2] + d[3] * d[3]); }
    const float rstd = rsqrtf(wave_sum(q) * (1.0f / 1024.0f) + 1e-5f);
#pragma unroll
    for (int k = 0; k < 4; ++k) { const f32x4 gg = *(const f32x4*)(gw + 4 * lane + 256 * k), bb = *(const f32x4*)(bw + 4 * lane + 256 * k);
#pragma unroll
        for (int j = 0; j < 4; ++j) o[4 * k + j] = (v[k][j] - mu) * rstd * gg[j] + bb[j]; }
}
__device__ __forceinline__ void ln_row_bf16in(const bf16_t* x, const float* gw, const float* bw, int lane, float (&o)[16]) {
    f32x4 v[4];
#pragma unroll
    for (int k = 0; k < 4; ++k) { const u32x2 u = *(const u32x2*)(x + 4 * lane + 256 * k); v[k] = (f32x4){bf_lo(u.x), bf_hi(u.x), bf_lo(u.y), bf_hi(u.y)}; }
    float s = 0.f;
#pragma unroll
    for (int k = 0; k < 4; ++k) s += (v[k][0] + v[k][1]) + (v[k][2] + v[k][3]);
    const float mu = wave_sum(s) * (1.0f / 1024.0f);
    float q = 0.f;
#pragma unroll
    for (int k = 0; k < 4; ++k) { const f32x4 d = v[k] - mu; q += (d[0] * d[0] + d[1] * d[1]) + (d[2] * d[2] + d[3] * d[3]); }
    const float rstd = rsqrtf(wave_sum(q) * (1.0f / 1024.0f) + 1e-5f);
#pragma unroll
    for (int k = 0; k < 4; ++k) { const f32x4 gg = *(const f32x4*)(gw + 4 * lane + 256 * k), bb = *(const f32x4*)(bw + 4 * lane + 256 * k);
#pragma unroll
        for (int j = 0; j < 4; ++j) o[4 * k + j] = (v[k][j] - mu) * rstd * gg[j] + bb[j]; }
}
__device__ __forceinline__ void store_row_bf16(bf16_t* dst, int lane, const float (&o)[16]) {
#pragma unroll
    for (int k = 0; k < 4; ++k) { u32x2 w; w.x = cvt_pk_bf16(o[4 * k], o[4 * k + 1]); w.y = cvt_pk_bf16(o[4 * k + 2], o[4 * k + 3]); *(u32x2*)(dst + 4 * lane + 256 * k) = w; }
}
__device__ __forceinline__ void cvtT(const float* src, int K, int Nsrc, bf16_t* dst, int Ndst, int mode, int gw, int nW, int lane) {
    const int nbn = Ndst / 64, nit = nbn * (K / 8);
    for (int it = gw; it < nit; it += nW) {
        const int nb = it % nbn, kb = it / nbn, n = nb * 64 + lane, k0 = kb * 8;
        int col = n;
        if (mode == 1) {
            if (n < 4096) col = n;
            else if (n < 8192) { const int tt = (n - 4096) >> 8, w = (n - 4096) & 255, hf = w >> 7, ch = (tt & 7) * 128 + (w & 127);
                col = tt < 8 ? (hf == 0 ? 5136 + ch : 6160 + ch) : (hf == 0 ? 4112 + ch : 7184 + ch); }
            else col = n < 10240 ? n + 16 : (n < 10256 ? 4096 + (n - 10240) : -1);
        }
        float f[8];
#pragma unroll
        for (int j = 0; j < 8; ++j) f[j] = col >= 0 ? src[(size_t)(k0 + j) * Nsrc + col] : 0.f;
        *(u32x4*)(dst + (size_t)n * K + k0) = pack8(f);
    }
}
__device__ void ln_in_rows(const Params& p, int r_lo, int r_hi, int gw, int nW, int lane) {
    bf16_t* hbf = (bf16_t*)(p.ws + W_HBF); bf16_t* pbf = (bf16_t*)(p.ws + W_PBF);
    for (int r = r_lo + gw; r < r_hi; r += nW) {
        const int t = row2tok(r);
        const float* x = t < 32768 ? p.in[0] + (size_t)t * 1024 : p.in[1] + (size_t)(t - 32768) * 1024;
        const float* pp = t < 32768 ? p.in[5] + (size_t)t * 256 : p.in[6] + (size_t)(t - 32768) * 256;
        float o[16]; ln_row(x, p.in[7], p.in[8], lane, o); store_row_bf16(hbf + (size_t)r * 1024, lane, o);
        const f32x4 pv = *(const f32x4*)(pp + 4 * lane); u32x2 w; w.x = cvt_pk_bf16(pv[0], pv[1]); w.y = cvt_pk_bf16(pv[2], pv[3]); *(u32x2*)(pbf + (size_t)r * 256 + 4 * lane) = w;
    }
}
__device__ void cvt_small_weights(const Params& p, int gw, int nW, int lane) {
    cvtT(p.in[15], 1024, 1024, (bf16_t*)(p.ws + W_WA), 1024, 0, gw, nW, lane);
    cvtT(p.in[16], 1024, 1024, (bf16_t*)(p.ws + W_WB), 1024, 0, gw, nW, lane);
    cvtT(p.in[17], 1024, 1024, (bf16_t*)(p.ws + W_WO), 1024, 0, gw, nW, lane);
    cvtT(p.in[21], 1024, 1024, (bf16_t*)(p.ws + W_WG), 1024, 0, gw, nW, lane);
    cvtT(p.in[20], 256, 1024, (bf16_t*)(p.ws + W_WP), 1024, 0, gw, nW, lane);
}
__device__ void phase0(const Params& p) {
    const int tid = opaque_tid(), lane = tid & 63, wid = tid >> 6, gw = blockIdx.x * 8 + wid, nW = gridDim.x * 8;
    ln_in_rows(p, 0, SEGM, gw, nW, lane);
    cvtT(p.in[9], 1024, 10256, (bf16_t*)(p.ws + W_WIN), NZ, 1, gw, nW, lane);
    float* ha = (float*)(p.ws + W_HISTA); float* hb = (float*)(p.ws + W_HISTB);
    for (int i = blockIdx.x * 512 + tid; i < 2 * 3 * 3072; i += gridDim.x * 512) ha[i] = 0.f;
    for (int i = blockIdx.x * 512 + tid; i < 2 * 2 * 1024; i += gridDim.x * 512) hb[i] = 0.f;
}

constexpr int P_KR = 0, P_QR = 17408, P_KT = 34816;
constexpr int H_VT = 0, H_AM = 18432, H_TU = 34816, H_TW = 44032, H_SC = 53248;
__device__ __forceinline__ bf16x8 fragR(LAS unsigned char* base, int row, int stride, int ks, int g) { return *(const LAS bf16x8*)(base + row * stride + (32 * ks + 8 * g) * 2); }
__device__ __forceinline__ float sel4(const f32x4 a, int i) { return i == 0 ? a[0] : (i == 1 ? a[1] : (i == 2 ? a[2] : a[3])); }

struct S1Regs { unsigned qpk[16], kpk[16], vT[2][8]; float be, gg; };
__device__ __forceinline__ void s1_compute(const Params& p, int seg, int item, int wq, int lane, S1Regs& R) {
    const int lc = item >> 3, h = item & 7;
    const bool prompt = lc < 128; const int b = lc >> 6, c = lc & 63;
    const int rowbase = prompt ? b * 4096 + c * 64 : 8192 + 32 * (lc - 128); const int nvalid = prompt ? 64 : 32;
    const bf16_t* zq = (const bf16_t*)(p.ws + W_ZQ);
    const float* hist = prompt ? (const float*)(p.ws + W_HISTA) + (size_t)(seg * 2 + b) * 9216 : p.in[2] + (size_t)(8 * seg + (lc - 128)) * 9216;
    const bool hist_from_z = prompt && c > 0;
    unsigned xr[3][19];
#pragma unroll
    for (int pt = 0; pt < 3; ++pt) {
        const int ch = pt * 1024 + h * 128 + 2 * lane;
#pragma unroll
        for (int jj = 0; jj < 19; ++jj) {
            const int tt = 16 * wq + jj - 3;
            if (tt >= 0 || hist_from_z) { const int ttc = tt < nvalid - 1 ? tt : nvalid - 1; xr[pt][jj] = *(const unsigned*)(zq + (size_t)(rowbase + ttc) * 3072 + ch); }
            else { const float* rp = hist + (size_t)(3 + tt) * 3072 + ch; xr[pt][jj] = cvt_pk_bf16(rp[0], rp[1]); }
        }
    }
#pragma unroll
    for (int pt = 0; pt < 3; ++pt) {
        const int ch = pt * 1024 + h * 128 + 2 * lane;
        float cw[4][2];
#pragma unroll
        for (int j = 0; j < 4; ++j) { cw[j][0] = p.in[10][j * 3072 + ch]; cw[j][1] = p.in[10][j * 3072 + ch + 1]; }
#pragma unroll
        for (int i2 = 0; i2 < 8; ++i2) {
            float y[2][2];
#pragma unroll
            for (int q = 0; q < 2; ++q) {
                const int i = 2 * i2 + q; const bool valid = (16 * wq + i) < nvalid;
                float a0 = bf_lo(xr[pt][i]) * cw[0][0], a1 = bf_hi(xr[pt][i]) * cw[0][1];
#pragma unroll
                for (int k = 1; k < 4; ++k) { a0 += bf_lo(xr[pt][i + k]) * cw[k][0]; a1 += bf_hi(xr[pt][i + k]) * cw[k][1]; }
                y[q][0] = valid ? siluf_(a0) : 0.f; y[q][1] = valid ? siluf_(a1) : 0.f;
            }
            if (pt == 0) { R.qpk[2 * i2] = cvt_pk_bf16(y[0][0], y[0][1]); R.qpk[2 * i2 + 1] = cvt_pk_bf16(y[1][0], y[1][1]); }
            else if (pt == 1) { R.kpk[2 * i2] = cvt_pk_bf16(y[0][0], y[0][1]); R.kpk[2 * i2 + 1] = cvt_pk_bf16(y[1][0], y[1][1]); }
            else { R.vT[0][i2] = cvt_pk_bf16(y[0][0], y[1][0]); R.vT[1][i2] = cvt_pk_bf16(y[0][1], y[1][1]); }
        }
    }
    if (wq == 0) {
        const float* bd = (const float*)(p.ws + W_BD);
        const int ic = lane < nvalid ? lane : nvalid - 1;
        const float bv = bd[(size_t)(rowbase + ic) * 16 + h], dv = bd[(size_t)(rowbase + ic) * 16 + 8 + h];
        const float xx = dv + p.in[12][h];
        const float sp = xx > 20.f ? xx : log1pf(__expf(xx));
        float gg = lane < nvalid ? -__expf(p.in[11][h]) * sp : 0.f;
        R.be = lane < nvalid ? sigmoidf_(bv) : 0.f;
#pragma unroll
        for (int d = 1; d < 64; d <<= 1) { const float t = __shfl_up(gg, d); if (lane >= d) gg += t; }
        R.gg = gg;
    }
}
__device__ __forceinline__ void s1_write(LAS unsigned char* lo, LAS unsigned char* hi, int wq, int lane, const S1Regs& R) {
#pragma unroll
    for (int i = 0; i < 16; ++i) { *(LAS unsigned*)(lo + P_QR + (16 * wq + i) * 272 + 4 * lane) = R.qpk[i]; *(LAS unsigned*)(lo + P_KR + (16 * wq + i) * 272 + 4 * lane) = R.kpk[i]; }
#pragma unroll
    for (int e = 0; e < 2; ++e)
#pragma unroll
        for (int hq = 0; hq < 2; ++hq) {
            u32x4 wk, wv;
#pragma unroll
            for (int j = 0; j < 4; ++j) { const unsigned a = R.kpk[8 * hq + 2 * j], b2 = R.kpk[8 * hq + 2 * j + 1];
                wk[j] = e == 0 ? ((a & 0xffffu) | (b2 << 16)) : ((a >> 16) | (b2 & 0xffff0000u)); wv[j] = R.vT[e][4 * hq + j]; }
            *(LAS u32x4*)(lo + P_KT + (2 * lane + e) * 144 + 32 * wq + 16 * hq) = wk;
            *(LAS u32x4*)(hi + H_VT + (2 * lane + e) * 144 + 32 * wq + 16 * hq) = wv;
        }
    if (wq == 0) { LAS float* SC = (LAS float*)(hi + H_SC); SC[lane] = R.be; SC[64 + lane] = R.gg; }
}
__device__ __forceinline__ void prep_item(const Params& p, int seg, int item, int next_item, S1Regs& R, LAS unsigned char* lds) {
    const int tid = opaque_tid(), lane = tid & 63, wid = __builtin_amdgcn_readfirstlane(tid >> 6), n = lane & 15, g = lane >> 4;
    const int lc = item >> 3, h = item & 7;
    unsigned char* ops = p.ws + W_OPS + (size_t)item * OPS_ITEM;
    LAS unsigned char* lo; LAS unsigned char* hi; { unsigned o0 = 0, o1 = 53248; asm volatile("" : "+v"(o0), "+v"(o1)); lo = lds + o0; hi = lds + o1; }
    LAS float* SC = (LAS float*)(hi + H_SC);
    if (wid >= 4) s1_write(lo, hi, wid - 4, lane, R);
    lds_barrier();
    const int it = wid >> 1, jh = wid & 1;
    f32x4 kka[2], qka[2];
    {
        bf16x8 ki[4], qi[4];
#pragma unroll
        for (int ks = 0; ks < 4; ++ks) { ki[ks] = fragR(lo + P_KR, 16 * it + n, 272, ks, g); qi[ks] = fragR(lo + P_QR, 16 * it + n, 272, ks, g); }
#pragma unroll
        for (int j2 = 0; j2 < 2; ++j2) {
            const int jt = 2 * jh + j2; f32x4 a = {0.f, 0.f, 0.f, 0.f}, q = {0.f, 0.f, 0.f, 0.f};
#pragma unroll
            for (int ks = 0; ks < 4; ++ks) { const bf16x8 kj = fragR(lo + P_KR, 16 * jt + n, 272, ks, g);
                a = __builtin_amdgcn_mfma_f32_16x16x32_bf16(ki[ks], kj, a, 0, 0, 0);
                q = __builtin_amdgcn_mfma_f32_16x16x32_bf16(kj, qi[ks], q, 0, 0, 0); }
            kka[j2] = a; qka[j2] = q;
        }
        f32x4 dg;
        const bool kdiag = (it >> 1) == jh;
        if (kdiag) dg = (it & 1) ? kka[1] : kka[0];
        else { dg = (f32x4){0.f, 0.f, 0.f, 0.f};
#pragma unroll
            for (int ks = 0; ks < 4; ++ks) dg = __builtin_amdgcn_mfma_f32_16x16x32_bf16(qi[ks], qi[ks], dg, 0, 0, 0); }
        const float dv = sel4(dg, n & 3);
        if (g == (n >> 2)) { if (kdiag) SC[192 + 16 * it + n] = rsqrtf(dv + 1e-6f); else SC[128 + 16 * it + n] = rsqrtf(dv + 1e-6f) * 0.08838834764831845f; }
    }
    lds_barrier();
    {
        bf16_t* qkg = (bf16_t*)(ops + 65536);
#pragma unroll
        for (int j2 = 0; j2 < 2; ++j2) {
            const int jt = 2 * jh + j2;
            { const int j = 16 * jt + n; const float rkj = SC[192 + j], gcj = SC[64 + j];
#pragma unroll
              for (int r = 0; r < 4; ++r) { const int i = 16 * it + 4 * g + r; const float df = SC[64 + i] - gcj;
                  const float v = (i > j) ? SC[i] * kka[j2][r] * SC[192 + i] * rkj * __expf(fminf(df, 0.f)) : 0.f;
                  *(LAS float*)(hi + H_AM + (i * 64 + j) * 4) = v; } }
            { const int i = 16 * it + n; const float rqi = SC[128 + i], gci = SC[64 + i]; float o[4];
#pragma unroll
              for (int r = 0; r < 4; ++r) { const int j = 16 * jt + 4 * g + r; const float df = gci - SC[64 + j];
                  o[r] = (i >= j) ? qka[j2][r] * rqi * SC[192 + j] * __expf(fminf(df, 0.f)) : 0.f; }
              u32x2 w; w.x = cvt_pk_bf16(o[0], o[1]); w.y = cvt_pk_bf16(o[2], o[3]);
              *(u32x2*)(qkg + i * 64 + 32 * (jt >> 1) + 8 * g + 4 * (jt & 1)) = w; }
        }
    }
    lds_barrier();
    if (wid < 4) {
        const LAS float* AM = (const LAS float*)(hi + H_AM);
        LAS float* TL; { unsigned o2 = 107520; asm volatile("" : "+v"(o2)); TL = (LAS float*)(lds + o2); }
        const int col = 16 * wid + n;
#pragma unroll 1
        for (int I = wid; I < 4; ++I) {
            float x[16];
            if (I > wid) {
                f32x4 acc = {0.f, 0.f, 0.f, 0.f};
#pragma unroll 1
                for (int J = wid; J < I; ++J) {
#pragma unroll
                    for (int ks = 0; ks < 4; ++ks)
                        acc = __builtin_amdgcn_mfma_f32_16x16x4f32(AM[(16 * I + n) * 64 + 16 * J + 4 * ks + g], TL[(16 * J + 4 * ks + g) * 64 + col], acc, 0, 0, 0);
                }
#pragma unroll
                for (int r = 0; r < 4; ++r) TL[(16 * I + 4 * g + r) * 64 + col] = -acc[r];
            }
#pragma unroll
            for (int r = 0; r < 16; ++r) { const float d = (16 * I + r) == col ? 1.f : 0.f; x[r] = I > wid ? TL[(16 * I + r) * 64 + col] + d : d; }
#pragma unroll
            for (int r = 1; r < 16; ++r) {
                f32x4 ar[4];
#pragma unroll
                for (int q = 0; q < (r + 3) / 4; ++q) ar[q] = *(const LAS f32x4*)(AM + (16 * I + r) * 64 + 16 * I + 4 * q);
                float s = x[r];
#pragma unroll
                for (int rp = 0; rp < r; ++rp) s -= ar[rp >> 2][rp & 3] * x[rp];
                x[r] = s;
            }
#pragma unroll
            for (int r = 0; r < 16; ++r) TL[(16 * I + r) * 64 + col] = x[r];
        }
        const float be = SC[col], sw = be * __expf(SC[64 + col]) * SC[192 + col];
        const bool zr = g < wid;
#pragma unroll 4
        for (int rr = 0; rr < 16; rr += 2) {
            const int i = 16 * g + rr;
            const float t0 = zr ? 0.f : TL[i * 64 + col], t1 = zr ? 0.f : TL[(i + 1) * 64 + col];
            const unsigned u = cvt_pk_bf16(t0 * be, t1 * be), w = cvt_pk_bf16(t0 * sw, t1 * sw);
            *(LAS bf16_t*)(hi + H_TU + i * 144 + 2 * col) = (bf16_t)(u & 0xffffu); *(LAS bf16_t*)(hi + H_TU + (i + 1) * 144 + 2 * col) = (bf16_t)(u >> 16);
            *(LAS bf16_t*)(hi + H_TW + i * 144 + 2 * col) = (bf16_t)(w & 0xffffu); *(LAS bf16_t*)(hi + H_TW + (i + 1) * 144 + 2 * col) = (bf16_t)(w >> 16);
        }
    } else {
        const float gcl = SC[64 + 63];
        for (int v = tid - 256; v < 2048; v += 256) {
            if (v < 1024) { const int i = v >> 4, c16 = v & 15; float f[8]; unpack8(*(const LAS u32x4*)(lo + P_QR + i * 272 + c16 * 16), f);
                const float s = SC[128 + i] * __expf(SC[64 + i]);
#pragma unroll
                for (int j = 0; j < 8; ++j) f[j] *= s;
                { const u32x4 pk = pack8(f); const int t = c16 >> 2, hf = (c16 >> 1) & 1, g1 = 2 * (c16 & 1);
                  bf16_t* dq = (bf16_t*)(ops + 16384) + i * 128 + 32 * t + 4 * hf;
                  *(u32x2*)(dq + 8 * g1) = (u32x2){pk.x, pk.y}; *(u32x2*)(dq + 8 * (g1 + 1)) = (u32x2){pk.z, pk.w}; }
            } else { const int vv = v - 1024, d = vv >> 3, c8 = vv & 7; float f[8]; unpack8(*(const LAS u32x4*)(lo + P_KT + d * 144 + c8 * 16), f);
#pragma unroll
                for (int j = 0; j < 8; ++j) { const int i = 8 * c8 + j; f[j] *= SC[192 + i] * __expf(gcl - SC[64 + i]); }
                { const u32x4 pk = pack8(f); const int t = c8 >> 2, hf = (c8 >> 1) & 1, g1 = 2 * (c8 & 1);
                  bf16_t* dk = (bf16_t*)(ops + 32768) + d * 64 + 32 * t + 4 * hf;
                  *(u32x2*)(dk + 8 * g1) = (u32x2){pk.x, pk.y}; *(u32x2*)(dk + 8 * (g1 + 1)) = (u32x2){pk.z, pk.w}; }
            }
        }
        if (tid == 256) ((float*)(p.ws + W_GL))[item] = __expf(gcl);
        if (next_item < 1088) s1_compute(p, seg, next_item, wid - 4, lane, R);
    }
    lds_barrier();
    {
        bf16x8 kt[2], vt[2];
#pragma unroll
        for (int ks = 0; ks < 2; ++ks) { kt[ks] = fragR(lo + P_KT, 16 * wid + n, 144, ks, g); vt[ks] = fragR(hi + H_VT, 16 * wid + n, 144, ks, g); }
        bf16_t* wg = (bf16_t*)ops; bf16_t* ug = (bf16_t*)(ops + 49152);
#pragma unroll
        for (int i4 = 0; i4 < 4; ++i4) {
            f32x4 wa = {0.f, 0.f, 0.f, 0.f}, ua = {0.f, 0.f, 0.f, 0.f};
#pragma unroll
            for (int ks = 0; ks < 2; ++ks) {
                wa = __builtin_amdgcn_mfma_f32_16x16x32_bf16(kt[ks], fragR(hi + (DBG_SKIP == 9 ? H_TU : H_TW), 16 * i4 + n, 144, ks, g), wa, 0, 0, 0);
                ua = __builtin_amdgcn_mfma_f32_16x16x32_bf16(fragR(hi + H_TU, 16 * i4 + n, 144, ks, g), vt[ks], ua, 0, 0, 0);
            }
            u32x2 w; w.x = cvt_pk_bf16(wa[0], wa[1]); w.y = cvt_pk_bf16(wa[2], wa[3]); *(u32x2*)(wg + (16 * i4 + n) * 128 + 32 * (wid >> 1) + 8 * g + 4 * (wid & 1)) = w;
            u32x2 u; u.x = cvt_pk_bf16(ua[0], ua[1]); u.y = cvt_pk_bf16(ua[2], ua[3]); *(u32x2*)(ug + (16 * wid + n) * 64 + 16 * i4 + 4 * g) = u;
        }
    }
    lds_barrier();
}

__device__ void yb_rows(const Params& p, int seg) {
    const int skipb = gridDim.x > 128 ? 64 : 0;
    if ((int)blockIdx.x < skipb) return;
    const int tid = opaque_tid(), lane = tid & 63, wid = tid >> 6, gw = ((int)blockIdx.x - skipb) * 8 + wid, nW = ((int)gridDim.x - skipb) * 8;
    const bf16_t* zb4 = (const bf16_t*)(p.ws + W_ZB4); const bf16_t* zq = (const bf16_t*)(p.ws + W_ZQ);
    bf16_t* yb = (bf16_t*)(p.ws + W_BUFB);
    for (int l = gw; l < SEGM; l += nW) {
        const size_t R = (size_t)seg * SEGM + l;
        const bool prompt = l < 8192; const int b = l >> 12, tl = prompt ? (l & 4095) : ((l - 8192) & 31), sq = 8 * seg + ((l - 8192) >> 5);
        const float* hb = prompt ? (const float*)(p.ws + W_HISTB) + (size_t)(seg * 2 + b) * 2048 : p.in[4] + (size_t)sq * 2048;
        const bf16_t* zr = zb4 + (size_t)l * 2048;
#pragma unroll
        for (int half = 0; half < 2; ++half) {
            const int c0 = 8 * lane + 512 * half;
            float cu[3][8];
#pragma unroll
            for (int k = 0; k < 3; ++k) {
                if (tl - k >= 0) { unpack8(*(const u32x4*)(zr - (size_t)k * 2048 + c0), cu[k]);
                } else { const float* hp = hb + (size_t)(2 + tl - k) * 1024 + c0;
#pragma unroll
                    for (int j = 0; j < 8; ++j) cu[k][j] = hp[j]; }
            }
            float bz[8], o[8]; unpack8(*(const u32x4*)(zr + 1024 + c0), bz);
#pragma unroll
            for (int j = 0; j < 8; ++j) { float cv = cu[2][j] * p.in[14][c0 + j]; cv += cu[1][j] * p.in[14][1024 + c0 + j]; cv += cu[0][j] * p.in[14][2048 + c0 + j]; o[j] = bz[j] * cv; }
            *(u32x4*)(yb + R * 1024 + c0) = pack8(o);
            if (prompt && tl >= 4094) { float* d = (float*)(p.ws + W_HISTB) + (size_t)((seg + 1) * 2 + b) * 2048 + (size_t)(tl - 4094) * 1024 + c0;
#pragma unroll
                for (int j = 0; j < 8; ++j) d[j] = cu[0][j];
                if (seg == NSEG - 1) { float* d2 = p.out + O_CBP + (size_t)b * 2048 + (size_t)(tl - 4094) * 1024 + c0;
#pragma unroll
                    for (int j = 0; j < 8; ++j) d2[j] = cu[0][j]; } }
            if (!prompt && tl >= 30) { float* d2 = p.out + O_CBS + (size_t)sq * 2048 + (size_t)(tl - 30) * 1024 + c0;
#pragma unroll
                for (int j = 0; j < 8; ++j) d2[j] = cu[0][j]; }
        }
        if ((prompt && tl >= 4093) || (!prompt && tl >= 29)) {
            const bf16_t* qr = zq + (size_t)l * 3072;
#pragma unroll
            for (int q = 0; q < 6; ++q) { const int c0 = 8 * lane + 512 * q; float f[8]; unpack8(*(const u32x4*)(qr + c0), f);
                if (prompt) { float* d = (float*)(p.ws + W_HISTA) + (size_t)((seg + 1) * 2 + b) * 9216 + (size_t)(tl - 4093) * 3072 + c0;
#pragma unroll
                    for (int j = 0; j < 8; ++j) d[j] = f[j];
                    if (seg == NSEG - 1) { float* d2 = p.out + O_CAP + (size_t)b * 9216 + (size_t)(tl - 4093) * 3072 + c0;
#pragma unroll
                        for (int j = 0; j < 8; ++j) d2[j] = f[j]; }
                } else { float* d2 = p.out + O_CAS + (size_t)sq * 9216 + (size_t)(tl - 29) * 3072 + c0;
#pragma unroll
                    for (int j = 0; j < 8; ++j) d2[j] = f[j]; }
            }
        }
    }
}
__device__ __forceinline__ void prep_phase(const Params& p, int seg, LAS unsigned char* lds) {
    S1Regs R;
    { const int tid0 = opaque_tid(), w0 = __builtin_amdgcn_readfirstlane(tid0 >> 6);
      if (w0 >= 4 && (int)blockIdx.x < 1088) s1_compute(p, seg, (int)blockIdx.x, w0 - 4, tid0 & 63, R); }
    for (int item = blockIdx.x; item < 1088; item += gridDim.x) prep_item(p, seg, item, item + (int)gridDim.x, R, lds);
    yb_rows(p, seg);
}

constexpr int S_W = 0, S_QD = 17408, S_KD = 34816, S_QK = 53248, S_BUF = 62464;
__device__ __forceinline__ bf16x8 fragP(LAS unsigned char* base, int row, int stride, int t, int g) {
    return *(const LAS bf16x8*)(base + row * stride + (32 * t + 8 * g) * 2);
}
__device__ __forceinline__ bf16x8 pack_frag(const f32x4 a, const f32x4 b) { u32x4 v; v.x = cvt_pk_bf16(a[0], a[1]); v.y = cvt_pk_bf16(a[2], a[3]); v.z = cvt_pk_bf16(b[0], b[1]); v.w = cvt_pk_bf16(b[2], b[3]); return __builtin_bit_cast(bf16x8, v); }

__device__ void scan_phase(const Params& p, int seg, LAS unsigned char* lds, bool dry = false, unsigned* done_ctr = nullptr) {
    const int tid = opaque_tid(), lane = tid & 63, wid = __builtin_amdgcn_readfirstlane(tid >> 6), n = lane & 15, g = lane >> 4;
    bf16_t* oseg = (bf16_t*)(p.ws + W_OSEG);
    const float* glb = (const float*)(p.ws + W_GL);
    for (int it = blockIdx.x; it < 80; it += gridDim.x) {
        if (DBG_SKIP >= 3 && it < 16) continue;
        const bool prompt = it < 16;
        const int b = it >> 3, h = it & 7, sj = (it - 16) >> 3, nsteps = prompt ? 64 : 1, nvalid = prompt ? 64 : 32;
        const float* sin; float* sout;
        if (prompt) { sout = p.out + O_SP + (size_t)(b * 8 + h) * 16384; sin = seg > 0 ? sout : nullptr; }
        else { const int sq = 8 * seg + sj; sin = p.in[3] + (size_t)(sq * 8 + h) * 16384; sout = p.out + O_SS + (size_t)(sq * 8 + h) * 16384; }
        f32x4 S[8];
#pragma unroll
        for (int t = 0; t < 8; ++t)
#pragma unroll
            for (int r = 0; r < 4; ++r) S[t][r] = sin ? sin[(size_t)(16 * t + 4 * g + r) * 128 + 16 * wid + n] : 0.f;
        const int item0 = (prompt ? b * 64 : 128 + sj) * 8 + h;
        const int rowbase0 = prompt ? b * 4096 : 8192 + 32 * sj;
        u32x4 st[1][7]; u32x2 un[1][4]; float gln[1];
#define SCAN_ISSUE(c_, k_) do { const unsigned char* ob = p.ws + W_OPS + (size_t)(item0 + 8 * (c_)) * OPS_ITEM; \
            _Pragma("unroll") for (int q = 0; q < 7; ++q) { const int v = tid + 512 * q; const size_t so = (q < 4 ? (size_t)v * 16 : (q < 6 ? 32768 + (size_t)(v - 2048) * 16 : 65536 + (size_t)(v - 3072) * 16)); st[k_][q] = *(const u32x4*)(ob + so); } \
            _Pragma("unroll") for (int mt = 0; mt < 4; ++mt) un[k_][mt] = *(const u32x2*)(ob + 49152 + (size_t)((16 * wid + n) * 64 + 16 * mt + 4 * g) * 2); \
            gln[k_] = glb[item0 + 8 * (c_)]; } while (0)
#define SCAN_COMMIT(buf_, k_) do { LAS unsigned char* cb = lds + (buf_) * S_BUF; \
            _Pragma("unroll") for (int q = 0; q < 7; ++q) { const int v = tid + 512 * q; int off; \
                if (q < 2) off = S_W + (v >> 4) * 272 + (v & 15) * 16; \
                else if (q < 4) off = S_QD + ((v - 1024) >> 4) * 272 + (v & 15) * 16; \
                else if (q < 6) off = S_KD + ((v - 2048) >> 3) * 144 + (v & 7) * 16; \
                else off = S_QK + ((v - 3072) >> 3) * 144 + (v & 7) * 16; \
                *(LAS u32x4*)(cb + off) = st[k_][q]; } \
            _Pragma("unroll") for (int mt = 0; mt < 4; ++mt) uc[mt] = un[k_][mt]; \
            gl = gln[k_]; } while (0)
        u32x2 uc[4]; float gl;
        auto compute = [&](int c) {
            LAS unsigned char* bb = lds + (c & 1) * S_BUF;
            bf16x8 Sb[4];
#pragma unroll
            for (int t = 0; t < 4; ++t) Sb[t] = pack_frag(S[2 * t], S[2 * t + 1]);
            bf16x8 F[2][4]; f32x4 vn[4], ao[4];
#define LD_RW(P, off, mt) do { _Pragma("unroll") for (int t = 0; t < 4; ++t) F[P][t] = fragP(bb + (off), 16 * (mt) + n, 272, t, g); } while (0)
#define LD_PR(P, off, r0) do { F[P][0] = fragP(bb + (off), 16 * (r0) + n, 144, 0, g); F[P][1] = fragP(bb + (off), 16 * (r0) + n, 144, 1, g); \
                               F[P][2] = fragP(bb + (off), 16 * ((r0) + 1) + n, 144, 0, g); F[P][3] = fragP(bb + (off), 16 * ((r0) + 1) + n, 144, 1, g); } while (0)
#define SBAR __builtin_amdgcn_sched_barrier(0)
#define VN_STEP(P, mt) do { f32x4 a = {0.f, 0.f, 0.f, 0.f}; _Pragma("unroll") for (int t = 0; t < 4; ++t) a = __builtin_amdgcn_mfma_f32_16x16x32_bf16(F[P][t], Sb[t], a, 0, 0, 0); \
            vn[mt][0] = bf_lo(uc[mt].x) - a[0]; vn[mt][1] = bf_hi(uc[mt].x) - a[1]; vn[mt][2] = bf_lo(uc[mt].y) - a[2]; vn[mt][3] = bf_hi(uc[mt].y) - a[3]; } while (0)
#define QD_STEP(P, mt) do { f32x4 a = {0.f, 0.f, 0.f, 0.f}; _Pragma("unroll") for (int t = 0; t < 4; ++t) a = __builtin_amdgcn_mfma_f32_16x16x32_bf16(Sb[t], F[P][t], a, 0, 0, 0); ao[mt] = a; } while (0)
#define O_STORE(mt) do { if (16 * (mt) + n < nvalid) { u32x2 w; w.x = cvt_pk_bf16(ao[mt][0], ao[mt][1]); w.y = cvt_pk_bf16(ao[mt][2], ao[mt][3]); \
            *(u32x2*)(oseg + (size_t)(rowb + 16 * (mt) + n) * 1024 + h * 128 + 16 * wid + 4 * g) = w; } } while (0)
#define QK_STEP(P, q) do { ao[2 * (q)] = __builtin_amdgcn_mfma_f32_16x16x32_bf16(vb[0], F[P][0], ao[2 * (q)], 0, 0, 0); ao[2 * (q)] = __builtin_amdgcn_mfma_f32_16x16x32_bf16(vb[1], F[P][1], ao[2 * (q)], 0, 0, 0); \
            ao[2 * (q) + 1] = __builtin_amdgcn_mfma_f32_16x16x32_bf16(vb[0], F[P][2], ao[2 * (q) + 1], 0, 0, 0); ao[2 * (q) + 1] = __builtin_amdgcn_mfma_f32_16x16x32_bf16(vb[1], F[P][3], ao[2 * (q) + 1], 0, 0, 0); \
            O_STORE(2 * (q)); O_STORE(2 * (q) + 1); } while (0)
#define KD_STEP(P, k) do { f32x4 a0 = S[2 * (k)] * gl, a1 = S[2 * (k) + 1] * gl; \
            a0 = __builtin_amdgcn_mfma_f32_16x16x32_bf16(F[P][0], vb[0], a0, 0, 0, 0); a1 = __builtin_amdgcn_mfma_f32_16x16x32_bf16(F[P][2], vb[0], a1, 0, 0, 0); \
            a0 = __builtin_amdgcn_mfma_f32_16x16x32_bf16(F[P][1], vb[1], a0, 0, 0, 0); a1 = __builtin_amdgcn_mfma_f32_16x16x32_bf16(F[P][3], vb[1], a1, 0, 0, 0); S[2 * (k)] = a0; S[2 * (k) + 1] = a1; } while (0)
            const int rowb = rowbase0 + 64 * c;
            LD_RW(0, S_W, 0); SBAR;
            LD_RW(1, S_W, 1); SBAR; VN_STEP(0, 0); SBAR;
            LD_RW(0, S_W, 2); SBAR; VN_STEP(1, 1); SBAR;
            LD_RW(1, S_W, 3); SBAR; VN_STEP(0, 2); SBAR;
            LD_RW(0, S_QD, 0); SBAR; VN_STEP(1, 3); SBAR;
            bf16x8 vb[2]; vb[0] = pack_frag(vn[0], vn[1]); vb[1] = pack_frag(vn[2], vn[3]);
            LD_RW(1, S_QD, 1); SBAR; QD_STEP(0, 0); SBAR;
            LD_RW(0, S_QD, 2); SBAR; QD_STEP(1, 1); SBAR;
            LD_RW(1, S_QD, 3); SBAR; QD_STEP(0, 2); SBAR;
            LD_PR(0, S_QK, 0); SBAR; QD_STEP(1, 3); SBAR;
            LD_PR(1, S_QK, 2); SBAR; QK_STEP(0, 0); SBAR;
            LD_PR(0, S_KD, 0); SBAR; QK_STEP(1, 1); SBAR;
            LD_PR(1, S_KD, 2); SBAR; KD_STEP(0, 0); SBAR;
            LD_PR(0, S_KD, 4); SBAR; KD_STEP(1, 1); SBAR;
            LD_PR(1, S_KD, 6); SBAR; KD_STEP(0, 2); SBAR;
            KD_STEP(1, 3); SBAR;
#undef LD_RW
#undef LD_PR
#undef SBAR
#undef VN_STEP
#undef QD_STEP
#undef O_STORE
#undef QK_STEP
#undef KD_STEP
        };
        SCAN_ISSUE(0, 0); SCAN_COMMIT(0, 0);
        lds_barrier();
        for (int c = 0; c < nsteps; ++c) {
            if (c + 1 < nsteps) SCAN_ISSUE(c + 1, 0);
            compute(c);
            if (c + 1 < nsteps) SCAN_COMMIT((c + 1) & 1, 0);
            lds_barrier();
        }
#undef SCAN_ISSUE
#undef SCAN_COMMIT
#pragma unroll
        for (int t = 0; t < 8; ++t)
#pragma unroll
            for (int r = 0; r < 4; ++r) { if (!dry) sout[(size_t)(16 * t + 4 * g + r) * 128 + 16 * wid + n] = S[t][r]; }
        if (done_ctr) {
            asm volatile("s_waitcnt vmcnt(0)" ::: "memory"); __syncthreads();
            if (threadIdx.x == 0) { __builtin_amdgcn_fence(__ATOMIC_RELEASE, "agent"); asm volatile("s_waitcnt vmcnt(0)" ::: "memory");
                (void)__hip_atomic_fetch_add(done_ctr, 1u, __ATOMIC_RELAXED, __HIP_MEMORY_SCOPE_AGENT); }
        }
    }
}

__device__ void ya_phase(const Params& p, int seg, int skipb = 0) {
    if ((int)blockIdx.x < skipb) return;
    const int tid = opaque_tid(), lane = tid & 63, wid = tid >> 6, gw = ((int)blockIdx.x - skipb) * 8 + wid, nW = ((int)gridDim.x - skipb) * 8;
    const bf16_t* oseg = (const bf16_t*)(p.ws + W_OSEG); bf16_t* za = (bf16_t*)(p.ws + W_BUFA);
    for (int l = gw; l < SEGM; l += nW) {
        const size_t R = (size_t)seg * SEGM + l; const int c0 = 16 * lane;
        float o[16], z[16];
        unpack8(*(const u32x4*)(oseg + (size_t)l * 1024 + c0), o); unpack8(*(const u32x4*)(oseg + (size_t)l * 1024 + c0 + 8), o + 8);
        unpack8(*(const u32x4*)(za + R * 1024 + c0), z); unpack8(*(const u32x4*)(za + R * 1024 + c0 + 8), z + 8);
        float ss = 0.f;
#pragma unroll
        for (int j = 0; j < 16; ++j) ss += o[j] * o[j];
        ss += __shfl_xor(ss, 1); ss += __shfl_xor(ss, 2); ss += __shfl_xor(ss, 4);
        const float rs = rsqrtf(ss * (1.0f / 128.0f) + 1e-6f);
        float y[16];
#pragma unroll
        for (int j = 0; j < 16; ++j) y[j] = o[j] * rs * p.in[13][(c0 + j) & 127] * siluf_(z[j]);
        *(u32x4*)(za + R * 1024 + c0) = pack8(y); *(u32x4*)(za + R * 1024 + c0 + 8) = pack8(y + 8);
    }
}
__device__ void ln1_phase(const Params& p) {
    const int tid = opaque_tid(), lane = tid & 63, wid = tid >> 6, gw = blockIdx.x * 8 + wid, nW = gridDim.x * 8;
    bf16_t* h1 = (bf16_t*)(p.ws + W_BUFA);
    for (int r = gw; r < MROWS; r += nW) { float o[16]; ln_row_bf16in((const bf16_t*)p.out + (size_t)r * 1024, p.in[18], p.in[19], lane, o); store_row_bf16(h1 + (size_t)r * 1024, lane, o); }
}
__device__ void ln2_phase(const Params& p) {
    const int tid = opaque_tid(), lane = tid & 63, wid = tid >> 6, gw = blockIdx.x * 8 + wid, nW = gridDim.x * 8;
    for (int r = gw; r < MROWS; r += nW) { float o[16]; float* x = p.out + (size_t)row2tok(r) * 1024; ln_row_bf16in((const bf16_t*)(p.ws + W_BUFB) + (size_t)r * 1024, p.in[22], p.in[23], lane, o);
#pragma unroll
        for (int k = 0; k < 4; ++k) __builtin_nontemporal_store((f32x4)((f32x4){o[4 * k], o[4 * k + 1], o[4 * k + 2], o[4 * k + 3]}), (f32x4*)(x + 4 * lane + 256 * k)); }
}

#define XB_TMO      128
#define XB_XCNT(j)  (256  + 64 * (j))
#define XB_XSUB(j)  (1280 + 64 * (j))
#define XB_XGEN(j)  (2304 + 64 * (j))
#define XB_TOP      3328
#define XB_TOPGEN   3392
#define XCD_BAR_WORDS 3456
#define XB_SPIN_CAP (1u << 20)
__device__ __forceinline__ unsigned xb_ld(unsigned* p)              { return __hip_atomic_load(p, __ATOMIC_RELAXED, __HIP_MEMORY_SCOPE_AGENT); }
__device__ __forceinline__ unsigned xb_add(unsigned* p, unsigned v) { return __hip_atomic_fetch_add(p, v, __ATOMIC_RELAXED, __HIP_MEMORY_SCOPE_AGENT); }
__device__ __forceinline__ unsigned xb_xcc_id() { return (unsigned)__builtin_amdgcn_s_getreg((3 << 11) | 20) & 0xFu; }
#define XB_SPIN(cond, bar) do { unsigned _sp = 0; while (cond) { __builtin_amdgcn_s_sleep(1); \
    if ((++_sp & 255u) == 0u) { if (xb_ld(&(bar)[XB_TMO])) break; if (_sp > XB_SPIN_CAP) { atomicAdd(&(bar)[XB_TMO], 1u); break; } } } } while (0)
struct XcdBarrier { unsigned* bar; unsigned x; volatile LAS unsigned* st; };
__device__ __forceinline__ XcdBarrier xcd_barrier_post(unsigned* bar, volatile LAS unsigned* st) {
    XcdBarrier b; b.bar = bar; b.x = xb_xcc_id(); b.st = st;
    if (threadIdx.x == 0) (void)xb_add(&bar[XB_XCNT(b.x)], 1u);
    return b;
}
__device__ __forceinline__ void xcd_barrier_complete(unsigned* bar, unsigned x, unsigned& nloc, unsigned& nx) {
    const unsigned G = gridDim.x * gridDim.y * gridDim.z;
    unsigned sum, cnt, mine, sp = 0u;
    for (;;) {
        sum = 0u; cnt = 0u; mine = 0u;
#pragma unroll
        for (unsigned j = 0; j < 16; ++j) { const unsigned c = xb_ld(&bar[XB_XCNT(j)]); sum += c; cnt += (c > 0u) ? 1u : 0u; mine = (j == x) ? c : mine; }
        if (sum == G) break;
        __builtin_amdgcn_s_sleep(1);
        if ((++sp & 255u) == 0u) { if (xb_ld(&bar[XB_TMO])) break; if (sp > XB_SPIN_CAP) { atomicAdd(&bar[XB_TMO], 1u); break; } }
    }
    nloc = mine > 0u ? mine : 1u; nx = cnt > 0u ? cnt : 1u;
}
__device__ __forceinline__ void xcd_barrier(const XcdBarrier& b) {
    asm volatile("s_waitcnt vmcnt(0)" ::: "memory");
    __syncthreads();
    if (threadIdx.x == 0) {
        unsigned* bar = b.bar;
        __builtin_amdgcn_s_waitcnt(0);
        unsigned nloc = b.st[0], nx = b.st[1];
        if (nloc == 0u) { xcd_barrier_complete(bar, b.x, nloc, nx); b.st[0] = nloc; b.st[1] = nx; }
        const unsigned old = xb_add(&bar[XB_XSUB(b.x)], 1u);
        const unsigned gen = old / nloc;
        if (old + 1u == (gen + 1u) * nloc) {
            __builtin_amdgcn_fence(__ATOMIC_RELEASE, "agent");
            asm volatile("s_waitcnt vmcnt(0)" ::: "memory");
            const unsigned og = xb_add(&bar[XB_TOP], 1u);
            const unsigned tg = og / nx;
            if (og + 1u == (tg + 1u) * nx) xb_add(&bar[XB_TOPGEN], 1u);
            else XB_SPIN(xb_ld(&bar[XB_TOPGEN]) == tg, bar);
            __builtin_amdgcn_fence(__ATOMIC_ACQUIRE, "agent");
            xb_add(&bar[XB_XGEN(b.x)], 1u);
            asm volatile("s_waitcnt vmcnt(0)" ::: "memory");
        } else {
            XB_SPIN(xb_ld(&bar[XB_XGEN(b.x)]) == gen, bar);
            __builtin_amdgcn_fence(__ATOMIC_ACQUIRE, "agent");
            asm volatile("s_waitcnt vmcnt(0)" ::: "memory");
        }
    }
    __syncthreads();
}

__global__ void __launch_bounds__(512, 2) mk_fwd(Params p) {
    extern __shared__ __attribute__((aligned(16))) unsigned char shm[];
    LAS unsigned char* lds = (LAS unsigned char*)shm;
    cg::grid_group grid = cg::this_grid();
    unsigned char* ws = p.ws;
    volatile LAS unsigned* stw = (volatile LAS unsigned*)(lds + 131072);
    if (threadIdx.x == 0) { stw[0] = 0u; stw[1] = 0u; }
    __syncthreads();
    const XcdBarrier xb = xcd_barrier_post((unsigned*)(ws + W_BAR), stw);
    for (int ph = p.ph_lo; ph < p.ph_hi; ++ph) {
      for (int rep = 0; rep < (ph == REP_PH ? REP_N : 1); ++rep) {
        if (rep > 0) grid.sync();
        if (ph == 0) phase0(p);
        else if (ph == 1 || (ph >= 3 && ph <= 7 && (ph & 1))) {
            const int seg = ph == 1 ? 0 : ((ph - 3) >> 1) + 1, skip = ph == 1 ? 0 : 16;
            if (REP_PH == 103 && ph == 3) scan_phase(p, seg - 1, lds, true);
            if (ph != 1 && rep == 0) scan_phase(p, seg - 1, lds);
            F1 f{(bf16_t*)(ws + W_ZQ), (bf16_t*)(ws + W_BUFA), (bf16_t*)(ws + W_ZB4), (bf16_t*)p.out, (float*)(ws + W_BD), seg};
            run_gemm(lds, (const bf16_t*)(ws + W_HBF) + (size_t)seg * SEGM * 1024, (const bf16_t*)(ws + W_WIN), SEGM, NZ, 1024, f, skip);
            if (ph == 1) {
                const int G = (int)gridDim.x, rem = ((SEGM / 256) * (NZ / 256)) % G, first = rem;
                if ((int)blockIdx.x >= first) { const int t2 = opaque_tid(); ln_in_rows(p, SEGM, MROWS, ((int)blockIdx.x - first) * 8 + (t2 >> 6), (G - first) * 8, t2 & 63);
                    cvt_small_weights(p, ((int)blockIdx.x - first) * 8 + (t2 >> 6), (G - first) * 8, t2 & 63); }
            }
        }
        else if (ph >= 2 && ph <= 8) { const int seg = (ph - 2) >> 1; prep_phase(p, seg, lds); if (seg > 0) ya_phase(p, seg - 1, gridDim.x > 128 ? 64 : 0); }
        else if (ph == 9) { unsigned* ctr = (unsigned*)(ws + W_BAR) + 64;
            scan_phase(p, 3, lds, false, ctr);
            FB f{(bf16_t*)(ws + W_ZB4), (const bf16_t*)p.out}; run_gemm(lds, (const bf16_t*)(ws + W_BUFB), (const bf16_t*)(ws + W_WB), MROWS, 1024, 1024, f, 16);
            if ((int)blockIdx.x >= 64) {
                if (threadIdx.x == 0) { unsigned sp = 0; while (__hip_atomic_load(ctr, __ATOMIC_RELAXED, __HIP_MEMORY_SCOPE_AGENT) < 80u) { __builtin_amdgcn_s_sleep(4); if (++sp > (1u << 24)) break; }
                    __builtin_amdgcn_fence(__ATOMIC_ACQUIRE, "agent"); asm volatile("s_waitcnt vmcnt(0)" ::: "memory"); }
                __syncthreads();
                ya_phase(p, 3, 64);
            } }
        else if (ph == 10) { FA f{(bf16_t*)(ws + W_ZB4), (const bf16_t*)p.out}; run_gemm(lds, (const bf16_t*)(ws + W_BUFA), (const bf16_t*)(ws + W_WA), MROWS, 1024, 1024, f); }
        else if (ph == 11) { FO f{(bf16_t*)p.out, (const bf16_t*)(ws + W_HBF)}; run_gemm(lds, (const bf16_t*)(ws + W_ZB4), (const bf16_t*)(ws + W_WO), MROWS, 1024, 1024, f);
            FP2 f2{(bf16_t*)(ws + W_OPS)}; run_gemm(lds, (const bf16_t*)(ws + W_PBF), (const bf16_t*)(ws + W_WP), MROWS, 1024, 256, f2, 16); }
        else if (ph == 12) ln1_phase(p);
        else if (ph == 13) { FG2 f{(bf16_t*)(ws + W_BUFB), (const bf16_t*)(ws + W_BUFA), (const bf16_t*)(ws + W_OPS)}; run_gemm(lds, (const bf16_t*)(ws + W_BUFA), (const bf16_t*)(ws + W_WG), MROWS, 1024, 1024, f); }
        else ln2_phase(p);
      }
        if (ph + 1 < p.ph_hi) { if (p.ph_hi > NPH) grid.sync(); else xcd_barrier(xb); }
        if (REP_PH == 100 && ph == 10) { for (int q = 0; q < 20; ++q) grid.sync(); }
    }
    if (DBG_SKIP && p.ph_hi == NPH) {
        const size_t i0 = (size_t)blockIdx.x * 512 + threadIdx.x, st = (size_t)gridDim.x * 512;
        for (size_t i = i0; i < O_CAP; i += st) p.out[i] = 0.f;
        if (DBG_SKIP == 1) { for (size_t i = i0; i < 262144; i += st) p.out[O_SP + i] = 0.f; for (size_t i = i0; i < 4194304; i += st) p.out[O_SS + i] = 0.f; }
        if (DBG_SKIP >= 3) { for (size_t i = i0; i < 262144; i += st) p.out[O_SP + i] = 0.f; }
    }
}

extern "C" void kernel_launch(void* const* d_in, const int* in_sizes, int n_in, void* d_out, int out_size, void* d_ws, size_t ws_size, hipStream_t stream) {
    static int grid = 0;
    if (grid == 0) {
        if (n_in != 24 || out_size != 39442432 || ws_size < W_END) { fprintf(stderr, "kernel_launch: unexpected shapes (n_in %d out %d ws %zu need %zu)\n", n_in, out_size, ws_size, (size_t)W_END); grid = -1; return; }
        int dev = 0, cus = 0, per_cu = 0;
        hipGetDevice(&dev); hipDeviceGetAttribute(&cus, hipDeviceAttributeMultiprocessorCount, dev);
        if (hipFuncSetAttribute((const void*)mk_fwd, hipFuncAttributeMaxDynamicSharedMemorySize, LDS_BYTES) != hipSuccess) { fprintf(stderr, "hipFuncSetAttribute failed\n"); grid = -1; return; }
        if (hipOccupancyMaxActiveBlocksPerMultiprocessor(&per_cu, (const void*)mk_fwd, 512, LDS_BYTES) != hipSuccess || per_cu < 1) { fprintf(stderr, "occupancy query failed (%d)\n", per_cu); grid = -1; return; }
        grid = cus * 1;
        fprintf(stderr, "kernel_launch: grid %d (per_cu %d), ws need %zu have %zu\n", grid, per_cu, (size_t)W_END, ws_size);
    }
    if (grid < 0) return;
    if (hipMemsetAsync((char*)d_ws + W_BAR, 0, 16384, stream) != hipSuccess) { fprintf(stderr, "kernel_launch: memset of barrier words failed\n"); return; }
    Params p{};
    for (int i = 0; i < 24; ++i) p.in[i] = (const float*)d_in[i];
    p.out = (float*)d_out; p.ws = (unsigned char*)d_ws;
#if MK_MULTI
    for (int ph = 0; ph < NPH; ++ph) { p.ph_lo = ph; p.ph_hi = ph + 1; hipLaunchKernelGGL(mk_fwd, dim3(grid), dim3(512), LDS_BYTES, stream, p); }
#else
    p.ph_lo = 0; p.ph_hi = NPH;
    void* args[] = {&p};
    hipError_t e = hipLaunchCooperativeKernel((void*)mk_fwd, dim3(grid), dim3(512), args, LDS_BYTES, stream);
    if (e != hipSuccess) fprintf(stderr, "cooperative launch failed: %s (grid %d)\n", hipGetErrorString(e), grid);
#endif
}
```

```cpp
#include <hip/hip_runtime.h>
#include <hip/hip_cooperative_groups.h>
#include <cstdio>
namespace cg = cooperative_groups;

#ifndef DBG_SKIP
#define DBG_SKIP 0
#endif
#ifndef REP_PH
#define REP_PH -1
#endif
#ifndef REP_N
#define REP_N 1
#endif
#ifndef MK_MULTI
#define MK_MULTI 0
#endif

#define LAS __attribute__((address_space(3)))
typedef unsigned short bf16_t;
typedef short bf16x8 __attribute__((ext_vector_type(8)));
typedef float f32x4 __attribute__((ext_vector_type(4)));
typedef unsigned u32x4 __attribute__((ext_vector_type(4)));
typedef unsigned u32x2 __attribute__((ext_vector_type(2)));

constexpr int MROWS = 33792, SEGM = 8448, NSEG = 4, DM = 1024, NZ = 10496, PD = 256;
constexpr float ALPHA_C = 1.189207115002721f;
constexpr int NPH = 15;
constexpr int LDS_BYTES = 131072 + 16;
constexpr size_t O_Y = 0, O_CAP = 34603008, O_SP = 34621440, O_CBP = 34883584, O_CAS = 34887680, O_SS = 35182592, O_CBS = 39376896;
constexpr size_t W_WIN = 0;
constexpr size_t W_WA = W_WIN + (size_t)NZ * 1024 * 2;
constexpr size_t W_WB = W_WA + 2097152, W_WO = W_WB + 2097152, W_WG = W_WO + 2097152;
constexpr size_t W_WP = W_WG + 2097152;
constexpr size_t W_PBF = W_WP + 524288;
constexpr size_t W_HBF = W_PBF + (size_t)MROWS * 256 * 2;
constexpr size_t W_BUFA = W_HBF + (size_t)MROWS * 2048;
constexpr size_t W_BUFB = W_BUFA + (size_t)MROWS * 2048;
constexpr size_t W_ZQ = W_BUFB + (size_t)MROWS * 2048;
constexpr size_t W_ZB4 = W_ZQ + (size_t)SEGM * 3072 * 2;
constexpr size_t W_BD = W_ZB4 + (size_t)SEGM * 4096 * 2;
constexpr size_t W_OPS = W_BD + (size_t)SEGM * 64;
constexpr size_t OPS_ITEM = 73728;
constexpr size_t W_GL = W_OPS + 1088 * OPS_ITEM;
constexpr size_t W_OSEG = W_GL + 8192;
constexpr size_t W_HISTA = W_OSEG + (size_t)SEGM * 2048;
constexpr size_t W_HISTB = W_HISTA + 5 * 2 * 3 * 3072 * 4;
constexpr size_t W_BAR = W_HISTB + 5 * 2 * 2 * 1024 * 4;
constexpr size_t W_END = W_BAR + 16384;

struct Params { const float* in[24]; float* out; unsigned char* ws; int ph_lo, ph_hi; };

typedef __bf16 bf16x2_t __attribute__((ext_vector_type(2)));
typedef float f32x2_t __attribute__((ext_vector_type(2)));
__device__ __forceinline__ unsigned cvt_pk_bf16(float lo, float hi) { f32x2_t v = {lo, hi}; bf16x2_t b = __builtin_convertvector(v, bf16x2_t); return __builtin_bit_cast(unsigned, b); }
__device__ __forceinline__ float bf_lo(unsigned u) { return __uint_as_float(u << 16); }
__device__ __forceinline__ float bf_hi(unsigned u) { return __uint_as_float(u & 0xffff0000u); }
__device__ __forceinline__ float sigmoidf_(float x) { return __builtin_amdgcn_rcpf(1.0f + __expf(-x)); }
__device__ __forceinline__ float siluf_(float x) { return x * __builtin_amdgcn_rcpf(1.0f + __expf(-x)); }
__device__ __forceinline__ int opaque_tid() { int t = threadIdx.x; asm volatile("" : "+v"(t)); return t; }
__device__ __forceinline__ void lds_barrier() { asm volatile("s_waitcnt lgkmcnt(0)" ::: "memory"); __builtin_amdgcn_s_barrier(); asm volatile("" ::: "memory"); }
__device__ __forceinline__ float wave_sum(float v) {
#pragma unroll
    for (int m = 32; m >= 1; m >>= 1) v += __shfl_xor(v, m);
    return v;
}
__device__ __forceinline__ int row2tok(int r) { const int s = r / SEGM, l = r - s * SEGM; if (l < 4096) return 4096 * s + l; if (l < 8192) return 16384 + 4096 * s + (l - 4096); return 32768 + 256 * s + (l - 8192); }
__device__ __forceinline__ void unpack8(const u32x4 v, float* f) { f[0] = bf_lo(v.x); f[1] = bf_hi(v.x); f[2] = bf_lo(v.y); f[3] = bf_hi(v.y); f[4] = bf_lo(v.z); f[5] = bf_hi(v.z); f[6] = bf_lo(v.w); f[7] = bf_hi(v.w); }
__device__ __forceinline__ u32x4 pack8(const float* f) { u32x4 w; w.x = cvt_pk_bf16(f[0], f[1]); w.y = cvt_pk_bf16(f[2], f[3]); w.z = cvt_pk_bf16(f[4], f[5]); w.w = cvt_pk_bf16(f[6], f[7]); return w; }

namespace pg8 {
constexpr int BM = 256, BK = 64, HALF = 128, HTB = HALF * BK * 2, STAGE_BYTES = 8 * HTB, NXCD = 8, WGM = 8;
__host__ __device__ __forceinline__ int lds_byte(int r, int c) { const int st = (r >> 4) * 2 + (c >> 5), rr = r & 15, cc = c & 31, ob = rr * 64 + cc * 2; return st * 1024 + (ob ^ (((ob >> 9) & 1) << 5)); }
__host__ __device__ __forceinline__ void stage_rc(int b, int& R, int& C) { const int st = b / 1024, sb = b % 1024, swz = sb ^ (((sb >> 9) & 1) << 5); R = (st >> 1) * 16 + swz / 64; C = (st & 1) * 32 + (swz % 64) / 2; }
__host__ __device__ __forceinline__ int perm32(int rho) { const int n = rho >> 4, i = rho & 15; return 8 * (i >> 2) + 4 * n + (i & 3); }
struct Unit { int pm, pn; };
struct Gemm { const bf16_t* A; const bf16_t* Bt; int M, N, K; };
struct StaticOrder {
    int nM, nN, nwg, G, c;
    __host__ __device__ void init(int M, int N, int G_, int c_) { nM = M / BM; nN = N / BM; nwg = nM * nN; G = G_; c = c_; }
    __host__ __device__ bool next(int i, Unit& u) const {
        const long L = (long)i * G + c; if (L >= nwg) return false;
        int wgid = (int)L; { const int q = nwg / NXCD, r = nwg % NXCD, xcd = wgid % NXCD, off = wgid / NXCD; wgid = (xcd < r ? xcd * (q + 1) : r * (q + 1) + (xcd - r) * q) + off; }
        const int nig = WGM * nN, gid = wgid / nig, fm = gid * WGM, gsz = (nM - fm) < WGM ? (nM - fm) : WGM;
        u.pm = fm + ((wgid % nig) % gsz); u.pn = (wgid % nig) / gsz; return true;
    }
    __device__ __forceinline__ void a_ready(const Unit&) const {}
    __device__ __forceinline__ void done(const Unit&) const {}
};

template <class Epi, class Sched>
__device__ __forceinline__ void gemm_phase(LAS unsigned char* lds, const Gemm g, const Sched& S, const Epi& E) {
    const int tid = opaque_tid(), wid = __builtin_amdgcn_readfirstlane(tid >> 6), lane = tid & 63, wr = wid >> 2, wc = wid & 3, fr = lane & 15, fq = lane >> 4;
    const int K = g.K, nt = K / BK;
    unsigned voffA[2], voffB[2];
#pragma unroll
    for (int i = 0; i < 2; ++i) { int R, C; stage_rc(tid * 16 + i * 8192, R, C); const int Rb = ((R & ~31) + perm32(R & 31));
        voffA[i] = (unsigned)(R * K + C) * 2u; voffB[i] = (unsigned)(Rb * K + C) * 2u; }
    const size_t kstep = (size_t)(BK * 2);
    const size_t hstep = (size_t)HALF * K * 2;
    const size_t tstep = 2 * hstep;
    const unsigned ldsw = (unsigned)wid * 1024u;
    const int aoff = lds_byte(wr * 64 + fr, fq * 8), boff = lds_byte(wc * 32 + fr, fq * 8);
#define PG8_SA(b, h) (((b) * 2 + (h)) * HTB)
#define PG8_SB(b, h) ((4 + (b) * 2 + (h)) * HTB)
#define PG8_STAGE(bufoff, gbase, voff) do { _Pragma("unroll") for (int _i = 0; _i < 2; ++_i) \
        __builtin_amdgcn_global_load_lds((const unsigned*)((const char*)(gbase) + (voff)[_i]), (LAS unsigned*)(lds + (bufoff) + ldsw + _i * 8192), 16, 0, 0); } while (0)
#define PG8_LDA(dst, b, h) do { _Pragma("unroll") for (int m = 0; m < 4; ++m) _Pragma("unroll") for (int k = 0; k < 2; ++k) dst[m][k] = *(const LAS bf16x8*)(lds + PG8_SA(b, h) + aoff + m * 2048 + k * 1024); } while (0)
#define PG8_LDB(dst, b, h) do { _Pragma("unroll") for (int n = 0; n < 2; ++n) _Pragma("unroll") for (int k = 0; k < 2; ++k) dst[n][k] = *(const LAS bf16x8*)(lds + PG8_SB(b, h) + boff + n * 2048 + k * 1024); } while (0)
#define PG8_MMA(ai, bj, At, Bt) do { __builtin_amdgcn_s_setprio(1); _Pragma("unroll") for (int m = 0; m < 4; ++m) _Pragma("unroll") for (int n = 0; n < 2; ++n) _Pragma("unroll") for (int k = 0; k < 2; ++k) \
        acc[ai][bj][m][n] = __builtin_amdgcn_mfma_f32_16x16x32_bf16(Bt[n][k], At[m][k], acc[ai][bj][m][n], 0, 0, 0); __builtin_amdgcn_s_setprio(0); } while (0)
#define PG8_WAIT_V(n) asm volatile("s_waitcnt vmcnt(" #n ")" ::: "memory")
#define PG8_WAIT_L(n) asm volatile("s_waitcnt lgkmcnt(" #n ")" ::: "memory")
#define PG8_BAR __builtin_amdgcn_s_barrier()
#define PG8_SCHED __builtin_amdgcn_sched_barrier(0)
    Unit cur, nxt; int ui = 0;
    if (!S.next(0, cur)) return;
    f32x4 acc[2][2][4][2];
#pragma unroll
    for (int a = 0; a < 2; ++a)
#pragma unroll
        for (int b = 0; b < 2; ++b)
#pragma unroll
            for (int m = 0; m < 4; ++m)
#pragma unroll
                for (int n = 0; n < 2; ++n) acc[a][b][m][n] = (f32x4){0.f, 0.f, 0.f, 0.f};
    bf16x8 At[4][2], B0[2][2], B1[2][2];
    const char* cA = (const char*)g.A + (size_t)cur.pm * tstep; const char* cB = (const char*)g.Bt + (size_t)cur.pn * tstep;
    S.a_ready(cur);
    PG8_STAGE(PG8_SB(0, 0), cB, voffB); PG8_STAGE(PG8_SA(0, 0), cA, voffA); PG8_STAGE(PG8_SB(0, 1), cB + hstep, voffB); PG8_STAGE(PG8_SA(0, 1), cA + hstep, voffA);
    if (wr == 1) PG8_BAR;
    PG8_WAIT_V(4); PG8_BAR;
    PG8_STAGE(PG8_SB(1, 0), cB + kstep, voffB); PG8_STAGE(PG8_SA(1, 0), cA + kstep, voffA); PG8_STAGE(PG8_SB(1, 1), cB + hstep + kstep, voffB);
    PG8_WAIT_V(6); PG8_BAR;
    for (;;) {
        const bool has_next = S.next(ui + 1, nxt);
        const char* nA = has_next ? (const char*)g.A + (size_t)nxt.pm * tstep : cA; const char* nB = has_next ? (const char*)g.Bt + (size_t)nxt.pn * tstep : cB;
#pragma unroll 1
        for (int t = 0; t < nt; t += 2) {
            const bool last = (t == nt - 2);
            const char* a1 = cA + (size_t)(t + 1) * kstep;
            const char* a2 = last ? nA : cA + (size_t)(t + 2) * kstep; const char* b2 = last ? nB : cB + (size_t)(t + 2) * kstep;
            const char* a3 = a2 + kstep; const char* b3 = b2 + kstep;
            if (last && has_next) S.a_ready(nxt);
            PG8_LDB(B0, 0, 0); PG8_SCHED; PG8_LDA(At, 0, 0); PG8_STAGE(PG8_SA(1, 1), a1 + hstep, voffA);
            PG8_WAIT_L(8); PG8_BAR; PG8_WAIT_L(0); PG8_MMA(0, 0, At, B0); PG8_BAR; PG8_SCHED;
            PG8_LDB(B1, 0, 1); PG8_STAGE(PG8_SB(0, 0), b2, voffB);
            PG8_BAR; PG8_WAIT_L(0); PG8_MMA(0, 1, At, B1); PG8_BAR;
            PG8_LDA(At, 0, 1); PG8_STAGE(PG8_SA(0, 0), a2, voffA);
            PG8_BAR; PG8_WAIT_L(0); PG8_MMA(1, 0, At, B0); PG8_BAR; PG8_SCHED;
            PG8_STAGE(PG8_SB(0, 1), b2 + hstep, voffB);
            PG8_WAIT_V(6); PG8_BAR; PG8_MMA(1, 1, At, B1); PG8_BAR;
            PG8_LDB(B0, 1, 0); PG8_SCHED; PG8_LDA(At, 1, 0); PG8_STAGE(PG8_SA(0, 1), a2 + hstep, voffA);
            PG8_WAIT_L(8); PG8_BAR; PG8_WAIT_L(0); PG8_MMA(0, 0, At, B0); PG8_BAR; PG8_SCHED;
            PG8_LDB(B1, 1, 1); PG8_STAGE(PG8_SB(1, 0), b3, voffB);
            PG8_BAR; PG8_WAIT_L(0); PG8_MMA(0, 1, At, B1); PG8_BAR;
            PG8_LDA(At, 1, 1); PG8_STAGE(PG8_SA(1, 0), a3, voffA);
            PG8_BAR; PG8_WAIT_L(0); PG8_MMA(1, 0, At, B0); PG8_BAR; PG8_SCHED;
            PG8_STAGE(PG8_SB(1, 1), b3 + hstep, voffB);
            PG8_WAIT_V(6); PG8_BAR; PG8_MMA(1, 1, At, B1); PG8_BAR;
        }
        E(acc, cur, wr, wc, fr, fq); S.done(cur);
        if (!has_next) break;
#pragma unroll
        for (int a = 0; a < 2; ++a)
#pragma unroll
            for (int b = 0; b < 2; ++b)
#pragma unroll
                for (int m = 0; m < 4; ++m)
#pragma unroll
                    for (int n = 0; n < 2; ++n) acc[a][b][m][n] = (f32x4){0.f, 0.f, 0.f, 0.f};
        cur = nxt; cA = nA; cB = nB; ++ui;
    }
    PG8_WAIT_V(0);
    if (wr == 0) PG8_BAR;
    PG8_BAR;
#undef PG8_SA
#undef PG8_SB
#undef PG8_STAGE
#undef PG8_LDA
#undef PG8_LDB
#undef PG8_MMA
#undef PG8_WAIT_V
#undef PG8_WAIT_L
#undef PG8_BAR
#undef PG8_SCHED
}
}

template <class F> struct EpiT {
    F f;
    __device__ __forceinline__ void operator()(const f32x4 (&acc)[2][2][4][2], const pg8::Unit& u, int wr, int wc, int fr, int fq) const {
        const int row0 = u.pm * 256 + wr * 64 + fr, col0 = u.pn * 256 + wc * 32 + 8 * fq;
        if constexpr (F::HAS_LOAD) {
            constexpr int PD = 4;
            typename F::LT buf[PD];
#pragma unroll
            for (int k = 0; k < PD; ++k) buf[k] = f.load(row0 + (k >> 3) * 128 + ((k >> 1) & 3) * 16, col0 + (k & 1) * 128);
#pragma unroll
            for (int idx = 0; idx < 16; ++idx) {
                const int ai = idx >> 3, m = (idx >> 1) & 3, bj = idx & 1;
                const typename F::LT cur = buf[idx % PD];
                if (idx + PD < 16) { const int i2 = idx + PD; buf[idx % PD] = f.load(row0 + (i2 >> 3) * 128 + ((i2 >> 1) & 3) * 16, col0 + (i2 & 1) * 128); }
                f.apply(row0 + ai * 128 + m * 16, col0 + bj * 128, acc[ai][bj][m][0], acc[ai][bj][m][1], cur); asm volatile("" ::: "memory");
            }
            return;
        }
#pragma unroll
        for (int ai = 0; ai < 2; ++ai)
#pragma unroll
            for (int m = 0; m < 4; ++m)
            {
                if constexpr (F::HAS_LOAD) { (void)ai; (void)m; break; }
                if constexpr (F::HAS_PAIR) { if (f.is_pair(u.pn)) { f.pair(row0 + ai * 128 + m * 16, col0, acc[ai][0][m][0], acc[ai][0][m][1], acc[ai][1][m][0], acc[ai][1][m][1]); asm volatile("" ::: "memory"); continue; } }
#pragma unroll
                for (int bj = 0; bj < 2; ++bj) { f(row0 + ai * 128 + m * 16, col0 + bj * 128, acc[ai][bj][m][0], acc[ai][bj][m][1]); asm volatile("" ::: "memory"); }
            }
    }
};
__device__ __forceinline__ u32x4 pack_v(const f32x4 v0, const f32x4 v1) { u32x4 w; w.x = cvt_pk_bf16(v0[0], v0[1]); w.y = cvt_pk_bf16(v0[2], v0[3]); w.z = cvt_pk_bf16(v1[0], v1[1]); w.w = cvt_pk_bf16(v1[2], v1[3]); return w; }

struct F1 {
    static constexpr bool HAS_LOAD = false;
    static constexpr bool HAS_PAIR = true;
    bf16_t* zq; bf16_t* za; bf16_t* zb4; bf16_t* gates; float* bd; int seg;
    __device__ __forceinline__ bool is_pair(int pn) const { return pn >= 16 && pn < 32; }
    __device__ __forceinline__ void pair(int row, int col, const f32x4 a0, const f32x4 a1, const f32x4 b0, const f32x4 b1) const {
        const int tt = (col - 4096) >> 8, ch = (tt & 7) * 128 + ((col - 4096) & 255); float o[8];
        if (tt < 8) {
#pragma unroll
            for (int j = 0; j < 4; ++j) { o[j] = a0[j] * b0[j]; o[4 + j] = a1[j] * b1[j]; }
            __builtin_nontemporal_store(pack8(o), (u32x4*)(zb4 + (size_t)row * 2048 + ch));
        } else {
#pragma unroll
            for (int j = 0; j < 4; ++j) { o[j] = a0[j] * siluf_(b0[j]); o[4 + j] = a1[j] * siluf_(b1[j]); }
            __builtin_nontemporal_store(pack8(o), (u32x4*)(zb4 + (size_t)row * 2048 + 1024 + ch));
        }
    }
    __device__ __forceinline__ void operator()(int row, int col, const f32x4 v0, const f32x4 v1) const {
        const size_t R = (size_t)seg * SEGM + row;
        if (col < 3072) __builtin_nontemporal_store(pack_v(v0, v1), (u32x4*)(zq + (size_t)row * 3072 + col));
        else if (col < 4096) __builtin_nontemporal_store(pack_v(v0, v1), (u32x4*)(za + R * 1024 + (col - 3072)));
        else if (col >= 8192 && col < 10240) __builtin_nontemporal_store(pack_v(v0, v1), (u32x4*)(gates + R * 2048 + (col - 8192)));
        else if (col >= 10240 && col < 10256) { float* d = bd + (size_t)row * 16 + (col - 10240); *(f32x4*)d = v0; *(f32x4*)(d + 4) = v1; }
    }
};
struct FB {
    static constexpr bool HAS_PAIR = false, HAS_LOAD = true;
    typedef u32x4 LT;
    bf16_t* mb; const bf16_t* gates;
    __device__ __forceinline__ LT load(int row, int col) const { return __builtin_nontemporal_load((const u32x4*)(gates + (size_t)row * 2048 + 1024 + col)); }
    __device__ __forceinline__ void apply(int row, int col, const f32x4 v0, const f32x4 v1, const LT& l) const {
        float gt[8]; unpack8(l, gt); float o[8];
#pragma unroll
        for (int j = 0; j < 4; ++j) { o[j] = sigmoidf_(gt[j]) * v0[j]; o[4 + j] = sigmoidf_(gt[4 + j]) * v1[j]; }
        *(u32x4*)(mb + (size_t)row * 1024 + col) = pack8(o);
    }
    __device__ __forceinline__ void operator()(int, int, const f32x4, const f32x4) const {}
};
struct FA {
    static constexpr bool HAS_PAIR = false, HAS_LOAD = true;
    struct LT { u32x4 g, m; };
    bf16_t* mb; const bf16_t* gates;
    __device__ __forceinline__ LT load(int row, int col) const { LT l; l.g = __builtin_nontemporal_load((const u32x4*)(gates + (size_t)row * 2048 + col)); l.m = __builtin_nontemporal_load((const u32x4*)(mb + (size_t)row * 1024 + col)); return l; }
    __device__ __forceinline__ void apply(int row, int col, const f32x4 v0, const f32x4 v1, const LT& l) const {
        float gt[8], pm[8]; unpack8(l.g, gt); unpack8(l.m, pm); float o[8];
#pragma unroll
        for (int j = 0; j < 4; ++j) { o[j] = sigmoidf_(gt[j]) * v0[j] + pm[j]; o[4 + j] = sigmoidf_(gt[4 + j]) * v1[j] + pm[4 + j]; }
        *(u32x4*)(mb + (size_t)row * 1024 + col) = pack8(o);
    }
    __device__ __forceinline__ void operator()(int, int, const f32x4, const f32x4) const {}
};
struct FO {
    static constexpr bool HAS_PAIR = false, HAS_LOAD = true;
    typedef u32x4 LT;
    bf16_t* pre; const bf16_t* hbf;
    __device__ __forceinline__ LT load(int row, int col) const { return __builtin_nontemporal_load((const u32x4*)(hbf + (size_t)row * 1024 + col)); }
    __device__ __forceinline__ void apply(int row, int col, const f32x4 v0, const f32x4 v1, const LT& l) const {
        float hv[8]; unpack8(l, hv); f32x4 a, b;
#pragma unroll
        for (int j = 0; j < 4; ++j) { a[j] = ALPHA_C * hv[j] + v0[j]; b[j] = ALPHA_C * hv[4 + j] + v1[j]; }
        *(u32x4*)(pre + (size_t)row * 1024 + col) = pack_v(a, b);
    }
    __device__ __forceinline__ void operator()(int, int, const f32x4, const f32x4) const {}
};
struct FG {
    static constexpr bool HAS_LOAD = false;
    static constexpr bool HAS_PAIR = false;
    bf16_t* gb;
    __device__ __forceinline__ void operator()(int row, int col, const f32x4 v0, const f32x4 v1) const {
        float o[8];
#pragma unroll
        for (int j = 0; j < 4; ++j) { o[j] = sigmoidf_(v0[j]); o[4 + j] = sigmoidf_(v1[j]); }
        *(u32x4*)(gb + (size_t)row * 1024 + col) = pack8(o);
    }
};
struct FP {
    static constexpr bool HAS_LOAD = false;
    static constexpr bool HAS_PAIR = false;
    float* out; const bf16_t* h1; const bf16_t* gb;
    __device__ __forceinline__ void operator()(int row, int col, const f32x4 v0, const f32x4 v1) const {
        float hv[8], gv[8]; unpack8(*(const u32x4*)(h1 + (size_t)row * 1024 + col), hv); unpack8(*(const u32x4*)(gb + (size_t)row * 1024 + col), gv); f32x4 a, b;
#pragma unroll
        for (int j = 0; j < 4; ++j) { a[j] = ALPHA_C * hv[j] + gv[j] * v0[j]; b[j] = ALPHA_C * hv[4 + j] + gv[4 + j] * v1[j]; }
        float* d = out + (size_t)row2tok(row) * 1024 + col; *(f32x4*)d = a; *(f32x4*)(d + 4) = b;
    }
};
struct FP2 {
    static constexpr bool HAS_LOAD = false;
    static constexpr bool HAS_PAIR = false;
    bf16_t* pb;
    __device__ __forceinline__ void operator()(int row, int col, const f32x4 v0, const f32x4 v1) const { *(u32x4*)(pb + (size_t)row * 1024 + col) = pack_v(v0, v1); }
};
struct FG2 {
    static constexpr bool HAS_PAIR = false, HAS_LOAD = true;
    struct LT { u32x4 h, pb; };
    bf16_t* out; const bf16_t* h1; const bf16_t* pb;
    __device__ __forceinline__ LT load(int row, int col) const { LT l; l.h = __builtin_nontemporal_load((const u32x4*)(h1 + (size_t)row * 1024 + col)); l.pb = __builtin_nontemporal_load((const u32x4*)(pb + (size_t)row * 1024 + col)); return l; }
    __device__ __forceinline__ void apply(int row, int col, const f32x4 v0, const f32x4 v1, const LT& l) const {
        float hv[8], pv[8]; unpack8(l.h, hv); unpack8(l.pb, pv); f32x4 a, b;
#pragma unroll
        for (int j = 0; j < 4; ++j) { a[j] = ALPHA_C * hv[j] + sigmoidf_(v0[j]) * pv[j]; b[j] = ALPHA_C * hv[4 + j] + sigmoidf_(v1[j]) * pv[4 + j]; }
        *(u32x4*)(out + (size_t)row * 1024 + col) = pack_v(a, b);
    }
    __device__ __forceinline__ void operator()(int, int, const f32x4, const f32x4) const {}
};
template <class F> __device__ __forceinline__ void run_gemm(LAS unsigned char* lds, const bf16_t* A, const bf16_t* Bt, int M, int N, int K, const F& f, int skip = 0) {
    if ((int)blockIdx.x < skip) return;
    pg8::Gemm g{A, Bt, M, N, K}; pg8::StaticOrder S; S.init(M, N, (int)gridDim.x - skip, (int)blockIdx.x - skip); EpiT<F> E{f};
    pg8::gemm_phase<EpiT<F>, pg8::StaticOrder>(lds, g, S, E);
}

__device__ __forceinline__ void ln_row(const float* x, const float* gw, const float* bw, int lane, float (&o)[16]) {
    f32x4 v[4];
#pragma unroll
    for (int k = 0; k < 4; ++k) v[k] = *(const f32x4*)(x + 4 * lane + 256 * k);
    float s = 0.f;
#pragma unroll
    for (int k = 0; k < 4; ++k) s += (v[k][0] + v[k][1]) + (v[k][2] + v[k][3]);
    const float mu = wave_sum(s) * (1.0f / 1024.0f);
    float q = 0.f;
#pragma unroll
    for (int k = 0; k < 4; ++k) { const f32x4 d = v[k] - mu; q += (d[0] * d[0] + d[1] * d[1]) + (d[2] * d[2] + d[3] * d[3]); }
    const float rstd = rsqrtf(wave_sum(q) * (1.0f / 1024.0f) + 1e-5f);
#pragma unroll
    for (int k = 0; k < 4; ++k) { const f32x4 gg = *(const f32x4*)(gw + 4 * lane + 256 * k), bb = *(const f32x4*)(bw + 4 * lane + 256 * k);
#pragma unroll
        for (int j = 0; j < 4; ++j) o[4 * k + j] = (v[k][j] - mu) * rstd * gg[j] + bb[j]; }
}
__device__ __forceinline__ void ln_row_bf16in(const bf16_t* x, const float* gw, const float* bw, int lane, float (&o)[16]) {
    f32x4 v[4];
#pragma unroll
    for (int k = 0; k < 4; ++k) { const u32x2 u = *(const u32x2*)(x + 4 * lane + 256 * k); v[k] = (f32x4){bf_lo(u.x), bf_hi(u.x), bf_lo(u.y), bf_hi(u.y)}; }
    float s = 0.f;
#pragma unroll
    for (int k = 0; k < 4; ++k) s += (v[k][0] + v[k][1]) + (v[k][2] + v[k][3]);
    const float mu = wave_sum(s) * (1.0f / 1024.0f);
    float q = 0.f;
#pragma unroll
    for (int k = 0; k < 4; ++k) { const f32x4 d = v[k] - mu; q += (d[0] * d[0] + d[1] * d[1]) + (d[2] * d[2] + d[3] * d[3]); }
    const float rstd = rsqrtf(wave_sum(q) * (1.0f / 1024.0f) + 1e-5f);
#pragma unroll
    for (int k = 0; k < 4; ++k) { const f32x4 gg = *(const f32x4*)(gw + 4 * lane + 256 * k), bb = *(const f32x4*)(bw + 4 * lane + 256 * k);
#pragma unroll
        for (int j = 0; j < 4; ++j) o[4 * k + j] = (v[k][j] - mu) * rstd * gg[j] + bb[j]; }
}
__device__ __forceinline__ void store_row_bf16(bf16_t* dst, int lane, const float (&o)[16]) {
#pragma unroll
    for (int k = 0; k < 4; ++k) { u32x2 w; w.x = cvt_pk_bf16(o[4 * k], o[4 * k + 1]); w.y = cvt_pk_bf16(o[4 * k + 2], o[4 * k + 3]); *(u32x2*)(dst + 4 * lane + 256 * k) = w; }
}
__device__ __forceinline__ void cvtT(const float* src, int K, int Nsrc, bf16_t* dst, int Ndst, int mode, int gw, int nW, int lane) {
    const int nbn = Ndst / 64, nit = nbn * (K / 8);
    for (int it = gw; it < nit; it += nW) {
        const int nb = it % nbn, kb = it / nbn, n = nb * 64 + lane, k0 = kb * 8;
        int col = n;
        if (mode == 1) {
            if (n < 4096) col = n;
            else if (n < 8192) { const int tt = (n - 4096) >> 8, w = (n - 4096) & 255, hf = w >> 7, ch = (tt & 7) * 128 + (w & 127);
                col = tt < 8 ? (hf == 0 ? 5136 + ch : 6160 + ch) : (hf == 0 ? 4112 + ch : 7184 + ch); }
            else col = n < 10240 ? n + 16 : (n < 10256 ? 4096 + (n - 10240) : -1);
        }
        float f[8];
#pragma unroll
        for (int j = 0; j < 8; ++j) f[j] = col >= 0 ? src[(size_t)(k0 + j) * Nsrc + col] : 0.f;
        *(u32x4*)(dst + (size_t)n * K + k0) = pack8(f);
    }
}
__device__ void ln_in_rows(const Params& p, int r_lo, int r_hi, int gw, int nW, int lane) {
    bf16_t* hbf = (bf16_t*)(p.ws + W_HBF); bf16_t* pbf = (bf16_t*)(p.ws + W_PBF);
    for (int r = r_lo + gw; r < r_hi; r += nW) {
        const int t = row2tok(r);
        const float* x = t < 32768 ? p.in[0] + (size_t)t * 1024 : p.in[1] + (size_t)(t - 32768) * 1024;
        const float* pp = t < 32768 ? p.in[5] + (size_t)t * 256 : p.in[6] + (size_t)(t - 32768) * 256;
        float o[16]; ln_row(x, p.in[7], p.in[8], lane, o); store_row_bf16(hbf + (size_t)r * 1024, lane, o);
        const f32x4 pv = *(const f32x4*)(pp + 4 * lane); u32x2 w; w.x = cvt_pk_bf16(pv[0], pv[1]); w.y = cvt_pk_bf16(pv[2], pv[3]); *(u32x2*)(pbf + (size_t)r * 256 + 4 * lane) = w;
    }
}
__device__ void cvt_small_weights(const Params& p, int gw, int nW, int lane) {
    cvtT(p.in[15], 1024, 1024, (bf16_t*)(p.ws + W_WA), 1024, 0, gw, nW, lane);
    cvtT(p.in[16], 1024, 1024, (bf16_t*)(p.ws + W_WB), 1024, 0, gw, nW, lane);
    cvtT(p.in[17], 1024, 1024, (bf16_t*)(p.ws + W_WO), 1024, 0, gw, nW, lane);
    cvtT(p.in[21], 1024, 1024, (bf16_t*)(p.ws + W_WG), 1024, 0, gw, nW, lane);
    cvtT(p.in[20], 256, 1024, (bf16_t*)(p.ws + W_WP), 1024, 0, gw, nW, lane);
}
__device__ void phase0(const Params& p) {
    const int tid = opaque_tid(), lane = tid & 63, wid = tid >> 6, gw = blockIdx.x * 8 + wid, nW = gridDim.x * 8;
    ln_in_rows(p, 0, SEGM, gw, nW, lane);
    cvtT(p.in[9], 1024, 10256, (bf16_t*)(p.ws + W_WIN), NZ, 1, gw, nW, lane);
    float* ha = (float*)(p.ws + W_HISTA); float* hb = (float*)(p.ws + W_HISTB);
    for (int i = blockIdx.x * 512 + tid; i < 2 * 3 * 3072; i += gridDim.x * 512) ha[i] = 0.f;
    for (int i = blockIdx.x * 512 + tid; i < 2 * 2 * 1024; i += gridDim.x * 512) hb[i] = 0.f;
}

constexpr int P_KR = 0, P_QR = 17408, P_KT = 34816;
constexpr int H_VT = 0, H_AM = 18432, H_TU = 34816, H_TW = 44032, H_SC = 53248;
__device__ __forceinline__ bf16x8 fragR(LAS unsigned char* base, int row, int stride, int ks, int g) { return *(const LAS bf16x8*)(base + row * stride + (32 * ks + 8 * g) * 2); }
__device__ __forceinline__ float sel4(const f32x4 a, int i) { return i == 0 ? a[0] : (i == 1 ? a[1] : (i == 2 ? a[2] : a[3])); }

struct S1Regs { unsigned qpk[16], kpk[16], vT[2][8]; float be, gg; };
__device__ __forceinline__ void s1_compute(const Params& p, int seg, int item, int wq, int lane, S1Regs& R) {
    const int lc = item >> 3, h = item & 7;
    const bool prompt = lc < 128; const int b = lc >> 6, c = lc & 63;
    const int rowbase = prompt ? b * 4096 + c * 64 : 8192 + 32 * (lc - 128); const int nvalid = prompt ? 64 : 32;
    const bf16_t* zq = (const bf16_t*)(p.ws + W_ZQ);
    const float* hist = prompt ? (const float*)(p.ws + W_HISTA) + (size_t)(seg * 2 + b) * 9216 : p.in[2] + (size_t)(8 * seg + (lc - 128)) * 9216;
    const bool hist_from_z = prompt && c > 0;
    unsigned xr[3][19];
#pragma unroll
    for (int pt = 0; pt < 3; ++pt) {
        const int ch = pt * 1024 + h * 128 + 2 * lane;
#pragma unroll
        for (int jj = 0; jj < 19; ++jj) {
            const int tt = 16 * wq + jj - 3;
            if (tt >= 0 || hist_from_z) { const int ttc = tt < nvalid - 1 ? tt : nvalid - 1; xr[pt][jj] = *(const unsigned*)(zq + (size_t)(rowbase + ttc) * 3072 + ch); }
            else { const float* rp = hist + (size_t)(3 + tt) * 3072 + ch; xr[pt][jj] = cvt_pk_bf16(rp[0], rp[1]); }
        }
    }
#pragma unroll
    for (int pt = 0; pt < 3; ++pt) {
        const int ch = pt * 1024 + h * 128 + 2 * lane;
        float cw[4][2];
#pragma unroll
        for (int j = 0; j < 4; ++j) { cw[j][0] = p.in[10][j * 3072 + ch]; cw[j][1] = p.in[10][j * 3072 + ch + 1]; }
#pragma unroll
        for (int i2 = 0; i2 < 8; ++i2) {
            float y[2][2];
#pragma unroll
            for (int q = 0; q < 2; ++q) {
                const int i = 2 * i2 + q; const bool valid = (16 * wq + i) < nvalid;
                float a0 = bf_lo(xr[pt][i]) * cw[0][0], a1 = bf_hi(xr[pt][i]) * cw[0][1];
#pragma unroll
                for (int k = 1; k < 4; ++k) { a0 += bf_lo(xr[pt][i + k]) * cw[k][0]; a1 += bf_hi(xr[pt][i + k]) * cw[k][1]; }
                y[q][0] = valid ? siluf_(a0) : 0.f; y[q][1] = valid ? siluf_(a1) : 0.f;
            }
            if (pt == 0) { R.qpk[2 * i2] = cvt_pk_bf16(y[0][0], y[0][1]); R.qpk[2 * i2 + 1] = cvt_pk_bf16(y[1][0], y[1][1]); }
            else if (pt == 1) { R.kpk[2 * i2] = cvt_pk_bf16(y[0][0], y[0][1]); R.kpk[2 * i2 + 1] = cvt_pk_bf16(y[1][0], y[1][1]); }
            else { R.vT[0][i2] = cvt_pk_bf16(y[0][0], y[1][0]); R.vT[1][i2] = cvt_pk_bf16(y[0][1], y[1][1]); }
        }
    }
    if (wq == 0) {
        const float* bd = (const float*)(p.ws + W_BD);
        const int ic = lane < nvalid ? lane : nvalid - 1;
        const float bv = bd[(size_t)(rowbase + ic) * 16 + h], dv = bd[(size_t)(rowbase + ic) * 16 + 8 + h];
        const float xx = dv + p.in[12][h];
        const float sp = xx > 20.f ? xx : log1pf(__expf(xx));
        float gg = lane < nvalid ? -__expf(p.in[11][h]) * sp : 0.f;
        R.be = lane < nvalid ? sigmoidf_(bv) : 0.f;
#pragma unroll
        for (int d = 1; d < 64; d <<= 1) { const float t = __shfl_up(gg, d); if (lane >= d) gg += t; }
        R.gg = gg;
    }
}
__device__ __forceinline__ void s1_write(LAS unsigned char* lo, LAS unsigned char* hi, int wq, int lane, const S1Regs& R) {
#pragma unroll
    for (int i = 0; i < 16; ++i) { *(LAS unsigned*)(lo + P_QR + (16 * wq + i) * 272 + 4 * lane) = R.qpk[i]; *(LAS unsigned*)(lo + P_KR + (16 * wq + i) * 272 + 4 * lane) = R.kpk[i]; }
#pragma unroll
    for (int e = 0; e < 2; ++e)
#pragma unroll
        for (int hq = 0; hq < 2; ++hq) {
            u32x4 wk, wv;
#pragma unroll
            for (int j = 0; j < 4; ++j) { const unsigned a = R.kpk[8 * hq + 2 * j], b2 = R.kpk[8 * hq + 2 * j + 1];
                wk[j] = e == 0 ? ((a & 0xffffu) | (b2 << 16)) : ((a >> 16) | (b2 & 0xffff0000u)); wv[j] = R.vT[e][4 * hq + j]; }
            *(LAS u32x4*)(lo + P_KT + (2 * lane + e) * 144 + 32 * wq + 16 * hq) = wk;
            *(LAS u32x4*)(hi + H_VT + (2 * lane + e) * 144 + 32 * wq + 16 * hq) = wv;
        }
    if (wq == 0) { LAS float* SC = (LAS float*)(hi + H_SC); SC[lane] = R.be; SC[64 + lane] = R.gg; }
}
__device__ __forceinline__ void prep_item(const Params& p, int seg, int item, int next_item, S1Regs& R, LAS unsigned char* lds) {
    const int tid = opaque_tid(), lane = tid & 63, wid = __builtin_amdgcn_readfirstlane(tid >> 6), n = lane & 15, g = lane >> 4;
    const int lc = item >> 3, h = item & 7;
    unsigned char* ops = p.ws + W_OPS + (size_t)item * OPS_ITEM;
    LAS unsigned char* lo; LAS unsigned char* hi; { unsigned o0 = 0, o1 = 53248; asm volatile("" : "+v"(o0), "+v"(o1)); lo = lds + o0; hi = lds + o1; }
    LAS float* SC = (LAS float*)(hi + H_SC);
    if (wid >= 4) s1_write(lo, hi, wid - 4, lane, R);
    lds_barrier();
    const int it = wid >> 1, jh = wid & 1;
    f32x4 kka[2], qka[2];
    {
        bf16x8 ki[4], qi[4];
#pragma unroll
        for (int ks = 0; ks < 4; ++ks) { ki[ks] = fragR(lo + P_KR, 16 * it + n, 272, ks, g); qi[ks] = fragR(lo + P_QR, 16 * it + n, 272, ks, g); }
#pragma unroll
        for (int j2 = 0; j2 < 2; ++j2) {
            const int jt = 2 * jh + j2; f32x4 a = {0.f, 0.f, 0.f, 0.f}, q = {0.f, 0.f, 0.f, 0.f};
#pragma unroll
            for (int ks = 0; ks < 4; ++ks) { const bf16x8 kj = fragR(lo + P_KR, 16 * jt + n, 272, ks, g);
                a = __builtin_amdgcn_mfma_f32_16x16x32_bf16(ki[ks], kj, a, 0, 0, 0);
                q = __builtin_amdgcn_mfma_f32_16x16x32_bf16(kj, qi[ks], q, 0, 0, 0); }
            kka[j2] = a; qka[j2] = q;
        }
        f32x4 dg;
        const bool kdiag = (it >> 1) == jh;
        if (kdiag) dg = (it & 1) ? kka[1] : kka[0];
        else { dg = (f32x4){0.f, 0.f, 0.f, 0.f};
#pragma unroll
            for (int ks = 0; ks < 4; ++ks) dg = __builtin_amdgcn_mfma_f32_16x16x32_bf16(qi[ks], qi[ks], dg, 0, 0, 0); }
        const float dv = sel4(dg, n & 3);
        if (g == (n >> 2)) { if (kdiag) SC[192 + 16 * it + n] = rsqrtf(dv + 1e-6f); else SC[128 + 16 * it + n] = rsqrtf(dv + 1e-6f) * 0.08838834764831845f; }
    }
    lds_barrier();
    {
        bf16_t* qkg = (bf16_t*)(ops + 65536);
#pragma unroll
        for (int j2 = 0; j2 < 2; ++j2) {
            const int jt = 2 * jh + j2;
            { const int j = 16 * jt + n; const float rkj = SC[192 + j], gcj = SC[64 + j];
#pragma unroll
              for (int r = 0; r < 4; ++r) { const int i = 16 * it + 4 * g + r; const float df = SC[64 + i] - gcj;
                  const float v = (i > j) ? SC[i] * kka[j2][r] * SC[192 + i] * rkj * __expf(fminf(df, 0.f)) : 0.f;
                  *(LAS float*)(hi + H_AM + (i * 64 + j) * 4) = v; } }
            { const int i = 16 * it + n; const float rqi = SC[128 + i], gci = SC[64 + i]; float o[4];
#pragma unroll
              for (int r = 0; r < 4; ++r) { const int j = 16 * jt + 4 * g + r; const float df = gci - SC[64 + j];
                  o[r] = (i >= j) ? qka[j2][r] * rqi * SC[192 + j] * __expf(fminf(df, 0.f)) : 0.f; }
              u32x2 w; w.x = cvt_pk_bf16(o[0], o[1]); w.y = cvt_pk_bf16(o[2], o[3]);
              *(u32x2*)(qkg + i * 64 + 32 * (jt >> 1) + 8 * g + 4 * (jt & 1)) = w; }
        }
    }
    lds_barrier();
    if (wid < 4) {
        const LAS float* AM = (const LAS float*)(hi + H_AM);
        LAS float* TL; { unsigned o2 = 107520; asm volatile("" : "+v"(o2)); TL = (LAS float*)(lds + o2); }
        const int col = 16 * wid + n;
#pragma unroll 1
        for (int I = wid; I < 4; ++I) {
            float x[16];
            if (I > wid) {
                f32x4 acc = {0.f, 0.f, 0.f, 0.f};
#pragma unroll 1
                for (int J = wid; J < I; ++J) {
#pragma unroll
                    for (int ks = 0; ks < 4; ++ks)
                        acc = __builtin_amdgcn_mfma_f32_16x16x4f32(AM[(16 * I + n) * 64 + 16 * J + 4 * ks + g], TL[(16 * J + 4 * ks + g) * 64 + col], acc, 0, 0, 0);
                }
#pragma unroll
                for (int r = 0; r < 4; ++r) TL[(16 * I + 4 * g + r) * 64 + col] = -acc[r];
            }
#pragma unroll
            for (int r = 0; r < 16; ++r) { const float d = (16 * I + r) == col ? 1.f : 0.f; x[r] = I > wid ? TL[(16 * I + r) * 64 + col] + d : d; }
#pragma unroll
            for (int r = 1; r < 16; ++r) {
                f32x4 ar[4];
#pragma unroll
                for (int q = 0; q < (r + 3) / 4; ++q) ar[q] = *(const LAS f32x4*)(AM + (16 * I + r) * 64 + 16 * I + 4 * q);
                float s = x[r];
#pragma unroll
                for (int rp = 0; rp < r; ++rp) s -= ar[rp >> 2][rp & 3] * x[rp];
                x[r] = s;
            }
#pragma unroll
            for (int r = 0; r < 16; ++r) TL[(16 * I + r) * 64 + col] = x[r];
        }
        const float be = SC[col], sw = be * __expf(SC[64 + col]) * SC[192 + col];
        const bool zr = g < wid;
#pragma unroll 4
        for (int rr = 0; rr < 16; rr += 2) {
            const int i = 16 * g + rr;
            const float t0 = zr ? 0.f : TL[i * 64 + col], t1 = zr ? 0.f : TL[(i + 1) * 64 + col];
            const unsigned u = cvt_pk_bf16(t0 * be, t1 * be), w = cvt_pk_bf16(t0 * sw, t1 * sw);
            *(LAS bf16_t*)(hi + H_TU + i * 144 + 2 * col) = (bf16_t)(u & 0xffffu); *(LAS bf16_t*)(hi + H_TU + (i + 1) * 144 + 2 * col) = (bf16_t)(u >> 16);
            *(LAS bf16_t*)(hi + H_TW + i * 144 + 2 * col) = (bf16_t)(w & 0xffffu); *(LAS bf16_t*)(hi + H_TW + (i + 1) * 144 + 2 * col) = (bf16_t)(w >> 16);
        }
    } else {
        const float gcl = SC[64 + 63];
        for (int v = tid - 256; v < 2048; v += 256) {
            if (v < 1024) { const int i = v >> 4, c16 = v & 15; float f[8]; unpack8(*(const LAS u32x4*)(lo + P_QR + i * 272 + c16 * 16), f);
                const float s = SC[128 + i] * __expf(SC[64 + i]);
#pragma unroll
                for (int j = 0; j < 8; ++j) f[j] *= s;
                { const u32x4 pk = pack8(f); const int t = c16 >> 2, hf = (c16 >> 1) & 1, g1 = 2 * (c16 & 1);
                  bf16_t* dq = (bf16_t*)(ops + 16384) + i * 128 + 32 * t + 4 * hf;
                  *(u32x2*)(dq + 8 * g1) = (u32x2){pk.x, pk.y}; *(u32x2*)(dq + 8 * (g1 + 1)) = (u32x2){pk.z, pk.w}; }
            } else { const int vv = v - 1024, d = vv >> 3, c8 = vv & 7; float f[8]; unpack8(*(const LAS u32x4*)(lo + P_KT + d * 144 + c8 * 16), f);
#pragma unroll
                for (int j = 0; j < 8; ++j) { const int i = 8 * c8 + j; f[j] *= SC[192 + i] * __expf(gcl - SC[64 + i]); }
                { const u32x4 pk = pack8(f); const int t = c8 >> 2, hf = (c8 >> 1) & 1, g1 = 2 * (c8 & 1);
                  bf16_t* dk = (bf16_t*)(ops + 32768) + d * 64 + 32 * t + 4 * hf;
                  *(u32x2*)(dk + 8 * g1) = (u32x2){pk.x, pk.y}; *(u32x2*)(dk + 8 * (g1 + 1)) = (u32x2){pk.z, pk.w}; }
            }
        }
        if (tid == 256) ((float*)(p.ws + W_GL))[item] = __expf(gcl);
        if (next_item < 1088) s1_compute(p, seg, next_item, wid - 4, lane, R);
    }
    lds_barrier();
    {
        bf16x8 kt[2], vt[2];
#pragma unroll
        for (int ks = 0; ks < 2; ++ks) { kt[ks] = fragR(lo + P_KT, 16 * wid + n, 144, ks, g); vt[ks] = fragR(hi + H_VT, 16 * wid + n, 144, ks, g); }
        bf16_t* wg = (bf16_t*)ops; bf16_t* ug = (bf16_t*)(ops + 49152);
#pragma unroll
        for (int i4 = 0; i4 < 4; ++i4) {
            f32x4 wa = {0.f, 0.f, 0.f, 0.f}, ua = {0.f, 0.f, 0.f, 0.f};
#pragma unroll
            for (int ks = 0; ks < 2; ++ks) {
                wa = __builtin_amdgcn_mfma_f32_16x16x32_bf16(kt[ks], fragR(hi + (DBG_SKIP == 9 ? H_TU : H_TW), 16 * i4 + n, 144, ks, g), wa, 0, 0, 0);
                ua = __builtin_amdgcn_mfma_f32_16x16x32_bf16(fragR(hi + H_TU, 16 * i4 + n, 144, ks, g), vt[ks], ua, 0, 0, 0);
            }
            u32x2 w; w.x = cvt_pk_bf16(wa[0], wa[1]); w.y = cvt_pk_bf16(wa[2], wa[3]); *(u32x2*)(wg + (16 * i4 + n) * 128 + 32 * (wid >> 1) + 8 * g + 4 * (wid & 1)) = w;
            u32x2 u; u.x = cvt_pk_bf16(ua[0], ua[1]); u.y = cvt_pk_bf16(ua[2], ua[3]); *(u32x2*)(ug + (16 * wid + n) * 64 + 16 * i4 + 4 * g) = u;
        }
    }
    lds_barrier();
}

__device__ void yb_rows(const Params& p, int seg) {
    const int skipb = gridDim.x > 128 ? 64 : 0;
    if ((int)blockIdx.x < skipb) return;
    const int tid = opaque_tid(), lane = tid & 63, wid = tid >> 6, gw = ((int)blockIdx.x - skipb) * 8 + wid, nW = ((int)gridDim.x - skipb) * 8;
    const bf16_t* zb4 = (const bf16_t*)(p.ws + W_ZB4); const bf16_t* zq = (const bf16_t*)(p.ws + W_ZQ);
    bf16_t* yb = (bf16_t*)(p.ws + W_BUFB);
    for (int l = gw; l < SEGM; l += nW) {
        const size_t R = (size_t)seg * SEGM + l;
        const bool prompt = l < 8192; const int b = l >> 12, tl = prompt ? (l & 4095) : ((l - 8192) & 31), sq = 8 * seg + ((l - 8192) >> 5);
        const float* hb = prompt ? (const float*)(p.ws + W_HISTB) + (size_t)(seg * 2 + b) * 2048 : p.in[4] + (size_t)sq * 2048;
        const bf16_t* zr = zb4 + (size_t)l * 2048;
#pragma unroll
        for (int half = 0; half < 2; ++half) {
            const int c0 = 8 * lane + 512 * half;
            float cu[3][8];
#pragma unroll
            for (int k = 0; k < 3; ++k) {
                if (tl - k >= 0) { unpack8(*(const u32x4*)(zr - (size_t)k * 2048 + c0), cu[k]);
                } else { const float* hp = hb + (size_t)(2 + tl - k) * 1024 + c0;
#pragma unroll
                    for (int j = 0; j < 8; ++j) cu[k][j] = hp[j]; }
            }
            float bz[8], o[8]; unpack8(*(const u32x4*)(zr + 1024 + c0), bz);
#pragma unroll
            for (int j = 0; j < 8; ++j) { float cv = cu[2][j] * p.in[14][c0 + j]; cv += cu[1][j] * p.in[14][1024 + c0 + j]; cv += cu[0][j] * p.in[14][2048 + c0 + j]; o[j] = bz[j] * cv; }
            *(u32x4*)(yb + R * 1024 + c0) = pack8(o);
            if (prompt && tl >= 4094) { float* d = (float*)(p.ws + W_HISTB) + (size_t)((seg + 1) * 2 + b) * 2048 + (size_t)(tl - 4094) * 1024 + c0;
#pragma unroll
                for (int j = 0; j < 8; ++j) d[j] = cu[0][j];
                if (seg == NSEG - 1) { float* d2 = p.out + O_CBP + (size_t)b * 2048 + (size_t)(tl - 4094) * 1024 + c0;
#pragma unroll
                    for (int j = 0; j < 8; ++j) d2[j] = cu[0][j]; } }
            if (!prompt && tl >= 30) { float* d2 = p.out + O_CBS + (size_t)sq * 2048 + (size_t)(tl - 30) * 1024 + c0;
#pragma unroll
                for (int j = 0; j < 8; ++j) d2[j] = cu[0][j]; }
        }
        if ((prompt && tl >= 4093) || (!prompt && tl >= 29)) {
            const bf16_t* qr = zq + (size_t)l * 3072;
#pragma unroll
            for (int q = 0; q < 6; ++q) { const int c0 = 8 * lane + 512 * q; float f[8]; unpack8(*(const u32x4*)(qr + c0), f);
                if (prompt) { float* d = (float*)(p.ws + W_HISTA) + (size_t)((seg + 1) * 2 + b) * 9216 + (size_t)(tl - 4093) * 3072 + c0;
#pragma unroll
                    for (int j = 0; j < 8; ++j) d[j] = f[j];
                    if (seg == NSEG - 1) { float* d2 = p.out + O_CAP + (size_t)b * 9216 + (size_t)(tl - 4093) * 3072 + c0;
#pragma unroll
                        for (int j = 0; j < 8; ++j) d2[j] = f[j]; }
                } else { float* d2 = p.out + O_CAS + (size_t)sq * 9216 + (size_t)(tl - 29) * 3072 + c0;
#pragma unroll
                    for (int j = 0; j < 8; ++j) d2[j] = f[j]; }
            }
        }
    }
}
__device__ __forceinline__ void prep_phase(const Params& p, int seg, LAS unsigned char* lds) {
    S1Regs R;
    { const int tid0 = opaque_tid(), w0 = __builtin_amdgcn_readfirstlane(tid0 >> 6);
      if (w0 >= 4 && (int)blockIdx.x < 1088) s1_compute(p, seg, (int)blockIdx.x, w0 - 4, tid0 & 63, R); }
    for (int item = blockIdx.x; item < 1088; item += gridDim.x) prep_item(p, seg, item, item + (int)gridDim.x, R, lds);
    yb_rows(p, seg);
}

constexpr int S_W = 0, S_QD = 17408, S_KD = 34816, S_QK = 53248, S_BUF = 62464;
__device__ __forceinline__ bf16x8 fragP(LAS unsigned char* base, int row, int stride, int t, int g) {
    return *(const LAS bf16x8*)(base + row * stride + (32 * t + 8 * g) * 2);
}
__device__ __forceinline__ bf16x8 pack_frag(const f32x4 a, const f32x4 b) { u32x4 v; v.x = cvt_pk_bf16(a[0], a[1]); v.y = cvt_pk_bf16(a[2], a[3]); v.z = cvt_pk_bf16(b[0], b[1]); v.w = cvt_pk_bf16(b[2], b[3]); return __builtin_bit_cast(bf16x8, v); }

__device__ void scan_phase(const Params& p, int seg, LAS unsigned char* lds, bool dry = false, unsigned* done_ctr = nullptr) {
    const int tid = opaque_tid(), lane = tid & 63, wid = __builtin_amdgcn_readfirstlane(tid >> 6), n = lane & 15, g = lane >> 4;
    bf16_t* oseg = (bf16_t*)(p.ws + W_OSEG);
    const float* glb = (const float*)(p.ws + W_GL);
    const bool remap = gridDim.x >= 240;
    for (int itb = blockIdx.x; itb < (remap ? 240 : 80); itb += gridDim.x) {
        int it = itb;
        if (remap) { if (itb >= 16 && itb < 176) continue; if (itb >= 176) it = 16 + (itb - 176); }
        const bool prompt = it < 16;
        const int b = it >> 3, h = it & 7, sj = (it - 16) >> 3, nsteps = prompt ? 64 : 1, nvalid = prompt ? 64 : 32;
        const float* sin; float* sout;
        if (prompt) { sout = p.out + O_SP + (size_t)(b * 8 + h) * 16384; sin = seg > 0 ? sout : nullptr; }
        else { const int sq = 8 * seg + sj; sin = p.in[3] + (size_t)(sq * 8 + h) * 16384; sout = p.out + O_SS + (size_t)(sq * 8 + h) * 16384; }
        f32x4 S[8];
#pragma unroll
        for (int t = 0; t < 8; ++t)
#pragma unroll
            for (int r = 0; r < 4; ++r) S[t][r] = sin ? sin[(size_t)(16 * t + 4 * g + r) * 128 + 16 * wid + n] : 0.f;
        const int item0 = (prompt ? b * 64 : 128 + sj) * 8 + h;
        const int rowbase0 = prompt ? b * 4096 : 8192 + 32 * sj;
        u32x4 st[1][7]; u32x2 un[1][4]; float gln[1];
#define SCAN_ISSUE(c_, k_) do { const unsigned char* ob = p.ws + W_OPS + (size_t)(item0 + 8 * (c_)) * OPS_ITEM; \
            _Pragma("unroll") for (int q = 0; q < 7; ++q) { const int v = tid + 512 * q; const size_t so = (q < 4 ? (size_t)v * 16 : (q < 6 ? 32768 + (size_t)(v - 2048) * 16 : 65536 + (size_t)(v - 3072) * 16)); st[k_][q] = *(const u32x4*)(ob + so); } \
            _Pragma("unroll") for (int mt = 0; mt < 4; ++mt) un[k_][mt] = *(const u32x2*)(ob + 49152 + (size_t)((16 * wid + n) * 64 + 16 * mt + 4 * g) * 2); \
            gln[k_] = glb[item0 + 8 * (c_)]; } while (0)
#define SCAN_COMMIT(buf_, k_) do { LAS unsigned char* cb = lds + (buf_) * S_BUF; \
            _Pragma("unroll") for (int q = 0; q < 7; ++q) { const int v = tid + 512 * q; int off; \
                if (q < 2) off = S_W + (v >> 4) * 272 + (v & 15) * 16; \
                else if (q < 4) off = S_QD + ((v - 1024) >> 4) * 272 + (v & 15) * 16; \
                else if (q < 6) off = S_KD + ((v - 2048) >> 3) * 144 + (v & 7) * 16; \
                else off = S_QK + ((v - 3072) >> 3) * 144 + (v & 7) * 16; \
                *(LAS u32x4*)(cb + off) = st[k_][q]; } \
            _Pragma("unroll") for (int mt = 0; mt < 4; ++mt) uc[mt] = un[k_][mt]; \
            gl = gln[k_]; } while (0)
        u32x2 uc[4]; float gl;
        auto compute = [&](int c) {
            LAS unsigned char* bb = lds + (c & 1) * S_BUF;
            bf16x8 Sb[4];
#pragma unroll
            for (int t = 0; t < 4; ++t) Sb[t] = pack_frag(S[2 * t], S[2 * t + 1]);
            bf16x8 F[2][4]; f32x4 vn[4], ao[4];
#define LD_RW(P, off, mt) do { _Pragma("unroll") for (int t = 0; t < 4; ++t) F[P][t] = fragP(bb + (off), 16 * (mt) + n, 272, t, g); } while (0)
#define LD_PR(P, off, r0) do { F[P][0] = fragP(bb + (off), 16 * (r0) + n, 144, 0, g); F[P][1] = fragP(bb + (off), 16 * (r0) + n, 144, 1, g); \
                               F[P][2] = fragP(bb + (off), 16 * ((r0) + 1) + n, 144, 0, g); F[P][3] = fragP(bb + (off), 16 * ((r0) + 1) + n, 144, 1, g); } while (0)
#define SBAR __builtin_amdgcn_sched_barrier(0)
#define VN_STEP(P, mt) do { f32x4 a = {0.f, 0.f, 0.f, 0.f}; _Pragma("unroll") for (int t = 0; t < 4; ++t) a = __builtin_amdgcn_mfma_f32_16x16x32_bf16(F[P][t], Sb[t], a, 0, 0, 0); \
            vn[mt][0] = bf_lo(uc[mt].x) - a[0]; vn[mt][1] = bf_hi(uc[mt].x) - a[1]; vn[mt][2] = bf_lo(uc[mt].y) - a[2]; vn[mt][3] = bf_hi(uc[mt].y) - a[3]; } while (0)
#define QD_STEP(P, mt) do { f32x4 a = {0.f, 0.f, 0.f, 0.f}; _Pragma("unroll") for (int t = 0; t < 4; ++t) a = __builtin_amdgcn_mfma_f32_16x16x32_bf16(Sb[t], F[P][t], a, 0, 0, 0); ao[mt] = a; } while (0)
#define O_STORE(mt) do { if (16 * (mt) + n < nvalid) { u32x2 w; w.x = cvt_pk_bf16(ao[mt][0], ao[mt][1]); w.y = cvt_pk_bf16(ao[mt][2], ao[mt][3]); \
            *(u32x2*)(oseg + (size_t)(rowb + 16 * (mt) + n) * 1024 + h * 128 + 16 * wid + 4 * g) = w; } } while (0)
#define QK_STEP(P, q) do { ao[2 * (q)] = __builtin_amdgcn_mfma_f32_16x16x32_bf16(vb[0], F[P][0], ao[2 * (q)], 0, 0, 0); ao[2 * (q)] = __builtin_amdgcn_mfma_f32_16x16x32_bf16(vb[1], F[P][1], ao[2 * (q)], 0, 0, 0); \
            ao[2 * (q) + 1] = __builtin_amdgcn_mfma_f32_16x16x32_bf16(vb[0], F[P][2], ao[2 * (q) + 1], 0, 0, 0); ao[2 * (q) + 1] = __builtin_amdgcn_mfma_f32_16x16x32_bf16(vb[1], F[P][3], ao[2 * (q) + 1], 0, 0, 0); \
            O_STORE(2 * (q)); O_STORE(2 * (q) + 1); } while (0)
#define KD_STEP(P, k) do { f32x4 a0 = S[2 * (k)] * gl, a1 = S[2 * (k) + 1] * gl; \
            a0 = __builtin_amdgcn_mfma_f32_16x16x32_bf16(F[P][0], vb[0], a0, 0, 0, 0); a1 = __builtin_amdgcn_mfma_f32_16x16x32_bf16(F[P][2], vb[0], a1, 0, 0, 0); \
            a0 = __builtin_amdgcn_mfma_f32_16x16x32_bf16(F[P][1], vb[1], a0, 0, 0, 0); a1 = __builtin_amdgcn_mfma_f32_16x16x32_bf16(F[P][3], vb[1], a1, 0, 0, 0); S[2 * (k)] = a0; S[2 * (k) + 1] = a1; } while (0)
            const int rowb = rowbase0 + 64 * c;
            LD_RW(0, S_W, 0); SBAR;
            LD_RW(1, S_W, 1); SBAR; VN_STEP(0, 0); SBAR;
            LD_RW(0, S_W, 2); SBAR; VN_STEP(1, 1); SBAR;
            LD_RW(1, S_W, 3); SBAR; VN_STEP(0, 2); SBAR;
            LD_RW(0, S_QD, 0); SBAR; VN_STEP(1, 3); SBAR;
            bf16x8 vb[2]; vb[0] = pack_frag(vn[0], vn[1]); vb[1] = pack_frag(vn[2], vn[3]);
            LD_RW(1, S_QD, 1); SBAR; QD_STEP(0, 0); SBAR;
            LD_RW(0, S_QD, 2); SBAR; QD_STEP(1, 1); SBAR;
            LD_RW(1, S_QD, 3); SBAR; QD_STEP(0, 2); SBAR;
            LD_PR(0, S_QK, 0); SBAR; QD_STEP(1, 3); SBAR;
            LD_PR(1, S_QK, 2); SBAR; QK_STEP(0, 0); SBAR;
            LD_PR(0, S_KD, 0); SBAR; QK_STEP(1, 1); SBAR;
            LD_PR(1, S_KD, 2); SBAR; KD_STEP(0, 0); SBAR;
            LD_PR(0, S_KD, 4); SBAR; KD_STEP(1, 1); SBAR;
            LD_PR(1, S_KD, 6); SBAR; KD_STEP(0, 2); SBAR;
            KD_STEP(1, 3); SBAR;
#undef LD_RW
#undef LD_PR
#undef SBAR
#undef VN_STEP
#undef QD_STEP
#undef O_STORE
#undef QK_STEP
#undef KD_STEP
        };
        SCAN_ISSUE(0, 0); SCAN_COMMIT(0, 0);
        lds_barrier();
        for (int c = 0; c < nsteps; ++c) {
            if (c + 1 < nsteps) SCAN_ISSUE(c + 1, 0);
            compute(c);
            if (c + 1 < nsteps) SCAN_COMMIT((c + 1) & 1, 0);
            lds_barrier();
        }
#undef SCAN_ISSUE
#undef SCAN_COMMIT
#pragma unroll
        for (int t = 0; t < 8; ++t)
#pragma unroll
            for (int r = 0; r < 4; ++r) { if (!dry) sout[(size_t)(16 * t + 4 * g + r) * 128 + 16 * wid + n] = S[t][r]; }
        if (done_ctr) {
            asm volatile("s_waitcnt vmcnt(0)" ::: "memory"); __syncthreads();
            if (threadIdx.x == 0) { __builtin_amdgcn_fence(__ATOMIC_RELEASE, "agent"); asm volatile("s_waitcnt vmcnt(0)" ::: "memory");
                (void)__hip_atomic_fetch_add(done_ctr, 1u, __ATOMIC_RELAXED, __HIP_MEMORY_SCOPE_AGENT); }
        }
    }
}

__device__ void ya_phase(const Params& p, int seg, int skipb = 0) {
    if ((int)blockIdx.x < skipb) return;
    const int tid = opaque_tid(), lane = tid & 63, wid = tid >> 6, gw = ((int)blockIdx.x - skipb) * 8 + wid, nW = ((int)gridDim.x - skipb) * 8;
    const bf16_t* oseg = (const bf16_t*)(p.ws + W_OSEG); bf16_t* za = (bf16_t*)(p.ws + W_BUFA);
    for (int l = gw; l < SEGM; l += nW) {
        const size_t R = (size_t)seg * SEGM + l; const int c0 = 16 * lane;
        float o[16], z[16];
        unpack8(*(const u32x4*)(oseg + (size_t)l * 1024 + c0), o); unpack8(*(const u32x4*)(oseg + (size_t)l * 1024 + c0 + 8), o + 8);
        unpack8(*(const u32x4*)(za + R * 1024 + c0), z); unpack8(*(const u32x4*)(za + R * 1024 + c0 + 8), z + 8);
        float ss = 0.f;
#pragma unroll
        for (int j = 0; j < 16; ++j) ss += o[j] * o[j];
        ss += __shfl_xor(ss, 1); ss += __shfl_xor(ss, 2); ss += __shfl_xor(ss, 4);
        const float rs = rsqrtf(ss * (1.0f / 128.0f) + 1e-6f);
        float y[16];
#pragma unroll
        for (int j = 0; j < 16; ++j) y[j] = o[j] * rs * p.in[13][(c0 + j) & 127] * siluf_(z[j]);
        *(u32x4*)(za + R * 1024 + c0) = pack8(y); *(u32x4*)(za + R * 1024 + c0 + 8) = pack8(y + 8);
    }
}
__device__ void ln1_phase(const Params& p) {
    const int tid = opaque_tid(), lane = tid & 63, wid = tid >> 6, gw = blockIdx.x * 8 + wid, nW = gridDim.x * 8;
    bf16_t* h1 = (bf16_t*)(p.ws + W_BUFA);
    for (int r = gw; r < MROWS; r += nW) { float o[16]; ln_row_bf16in((const bf16_t*)p.out + (size_t)r * 1024, p.in[18], p.in[19], lane, o); store_row_bf16(h1 + (size_t)r * 1024, lane, o); }
}
__device__ void ln2_phase(const Params& p) {
    const int tid = opaque_tid(), lane = tid & 63, wid = tid >> 6, gw = blockIdx.x * 8 + wid, nW = gridDim.x * 8;
    for (int r = gw; r < MROWS; r += nW) { float o[16]; float* x = p.out + (size_t)row2tok(r) * 1024; ln_row_bf16in((const bf16_t*)(p.ws + W_BUFB) + (size_t)r * 1024, p.in[22], p.in[23], lane, o);
#pragma unroll
        for (int k = 0; k < 4; ++k) __builtin_nontemporal_store((f32x4)((f32x4){o[4 * k], o[4 * k + 1], o[4 * k + 2], o[4 * k + 3]}), (f32x4*)(x + 4 * lane + 256 * k)); }
}

#define XB_TMO      128
#define XB_XCNT(j)  (256  + 64 * (j))
#define XB_XSUB(j)  (1280 + 64 * (j))
#define XB_XGEN(j)  (2304 + 64 * (j))
#define XB_TOP      3328
#define XB_TOPGEN   3392
#define XCD_BAR_WORDS 3456
#define XB_SPIN_CAP (1u << 20)
__device__ __forceinline__ unsigned xb_ld(unsigned* p)              { return __hip_atomic_load(p, __ATOMIC_RELAXED, __HIP_MEMORY_SCOPE_AGENT); }
__device__ __forceinline__ unsigned xb_add(unsigned* p, unsigned v) { return __hip_atomic_fetch_add(p, v, __ATOMIC_RELAXED, __HIP_MEMORY_SCOPE_AGENT); }
__device__ __forceinline__ unsigned xb_xcc_id() { return (unsigned)__builtin_amdgcn_s_getreg((3 << 11) | 20) & 0xFu; }
#define XB_SPIN(cond, bar) do { unsigned _sp = 0; while (cond) { __builtin_amdgcn_s_sleep(1); \
    if ((++_sp & 255u) == 0u) { if (xb_ld(&(bar)[XB_TMO])) break; if (_sp > XB_SPIN_CAP) { atomicAdd(&(bar)[XB_TMO], 1u); break; } } } } while (0)
struct XcdBarrier { unsigned* bar; unsigned x; volatile LAS unsigned* st; };
__device__ __forceinline__ XcdBarrier xcd_barrier_post(unsigned* bar, volatile LAS unsigned* st) {
    XcdBarrier b; b.bar = bar; b.x = xb_xcc_id(); b.st = st;
    if (threadIdx.x == 0) (void)xb_add(&bar[XB_XCNT(b.x)], 1u);
    return b;
}
__device__ __forceinline__ void xcd_barrier_complete(unsigned* bar, unsigned x, unsigned& nloc, unsigned& nx) {
    const unsigned G = gridDim.x * gridDim.y * gridDim.z;
    unsigned sum, cnt, mine, sp = 0u;
    for (;;) {
        sum = 0u; cnt = 0u; mine = 0u;
#pragma unroll
        for (unsigned j = 0; j < 16; ++j) { const unsigned c = xb_ld(&bar[XB_XCNT(j)]); sum += c; cnt += (c > 0u) ? 1u : 0u; mine = (j == x) ? c : mine; }
        if (sum == G) break;
        __builtin_amdgcn_s_sleep(1);
        if ((++sp & 255u) == 0u) { if (xb_ld(&bar[XB_TMO])) break; if (sp > XB_SPIN_CAP) { atomicAdd(&bar[XB_TMO], 1u); break; } }
    }
    nloc = mine > 0u ? mine : 1u; nx = cnt > 0u ? cnt : 1u;
}
__device__ __forceinline__ void xcd_barrier(const XcdBarrier& b) {
    asm volatile("s_waitcnt vmcnt(0)" ::: "memory");
    __syncthreads();
    if (threadIdx.x == 0) {
        unsigned* bar = b.bar;
        __builtin_amdgcn_s_waitcnt(0);
        unsigned nloc = b.st[0], nx = b.st[1];
        if (nloc == 0u) { xcd_barrier_complete(bar, b.x, nloc, nx); b.st[0] = nloc; b.st[1] = nx; }
        const unsigned old = xb_add(&bar[XB_XSUB(b.x)], 1u);
        const unsigned gen = old / nloc;
        if (old + 1u == (gen + 1u) * nloc) {
            __builtin_amdgcn_fence(__ATOMIC_RELEASE, "agent");
            asm volatile("s_waitcnt vmcnt(0)" ::: "memory");
            const unsigned og = xb_add(&bar[XB_TOP], 1u);
            const unsigned tg = og / nx;
            if (og + 1u == (tg + 1u) * nx) xb_add(&bar[XB_TOPGEN], 1u);
            else XB_SPIN(xb_ld(&bar[XB_TOPGEN]) == tg, bar);
            __builtin_amdgcn_fence(__ATOMIC_ACQUIRE, "agent");
            xb_add(&bar[XB_XGEN(b.x)], 1u);
            asm volatile("s_waitcnt vmcnt(0)" ::: "memory");
        } else {
            XB_SPIN(xb_ld(&bar[XB_XGEN(b.x)]) == gen, bar);
            __builtin_amdgcn_fence(__ATOMIC_ACQUIRE, "agent");
            asm volatile("s_waitcnt vmcnt(0)" ::: "memory");
        }
    }
    __syncthreads();
}

__global__ void __launch_bounds__(512, 2) mk_fwd(Params p) {
    extern __shared__ __attribute__((aligned(16))) unsigned char shm[];
    LAS unsigned char* lds = (LAS unsigned char*)shm;
    cg::grid_group grid = cg::this_grid();
    unsigned char* ws = p.ws;
    volatile LAS unsigned* stw = (volatile LAS unsigned*)(lds + 131072);
    if (threadIdx.x == 0) { stw[0] = 0u; stw[1] = 0u; }
    __syncthreads();
    const XcdBarrier xb = xcd_barrier_post((unsigned*)(ws + W_BAR), stw);
    for (int ph = p.ph_lo; ph < p.ph_hi; ++ph) {
      for (int rep = 0; rep < (ph == REP_PH ? REP_N : 1); ++rep) {
        if (rep > 0) grid.sync();
        if (ph == 0) phase0(p);
        else if (ph == 1 || (ph >= 3 && ph <= 7 && (ph & 1))) {
            const int seg = ph == 1 ? 0 : ((ph - 3) >> 1) + 1, skip = ph == 1 ? 0 : 16;
            if (REP_PH == 103 && ph == 3) scan_phase(p, seg - 1, lds, true);
            if (ph != 1 && rep == 0) scan_phase(p, seg - 1, lds);
            F1 f{(bf16_t*)(ws + W_ZQ), (bf16_t*)(ws + W_BUFA), (bf16_t*)(ws + W_ZB4), (bf16_t*)p.out, (float*)(ws + W_BD), seg};
            run_gemm(lds, (const bf16_t*)(ws + W_HBF) + (size_t)seg * SEGM * 1024, (const bf16_t*)(ws + W_WIN), SEGM, NZ, 1024, f, skip);
            if (ph == 1) {
                const int G = (int)gridDim.x, rem = ((SEGM / 256) * (NZ / 256)) % G, first = rem;
                if ((int)blockIdx.x >= first) { const int t2 = opaque_tid(); ln_in_rows(p, SEGM, MROWS, ((int)blockIdx.x - first) * 8 + (t2 >> 6), (G - first) * 8, t2 & 63);
                    cvt_small_weights(p, ((int)blockIdx.x - first) * 8 + (t2 >> 6), (G - first) * 8, t2 & 63); }
            }
        }
        else if (ph >= 2 && ph <= 8) { const int seg = (ph - 2) >> 1; prep_phase(p, seg, lds); if (seg > 0) ya_phase(p, seg - 1, gridDim.x > 128 ? 64 : 0); }
        else if (ph == 9) { unsigned* ctr = (unsigned*)(ws + W_BAR) + 64;
            scan_phase(p, 3, lds, false, ctr);
            FB f{(bf16_t*)(ws + W_ZB4), (const bf16_t*)p.out}; run_gemm(lds, (const bf16_t*)(ws + W_BUFB), (const bf16_t*)(ws + W_WB), MROWS, 1024, 1024, f, 16);
            if ((int)blockIdx.x >= 64) {
                if (threadIdx.x == 0) { unsigned sp = 0; while (__hip_atomic_load(ctr, __ATOMIC_RELAXED, __HIP_MEMORY_SCOPE_AGENT) < 80u) { __builtin_amdgcn_s_sleep(4); if (++sp > (1u << 24)) break; }
                    __builtin_amdgcn_fence(__ATOMIC_ACQUIRE, "agent"); asm volatile("s_waitcnt vmcnt(0)" ::: "memory"); }
                __syncthreads();
                ya_phase(p, 3, 64);
            } }
        else if (ph == 10) { FA f{(bf16_t*)(ws + W_ZB4), (const bf16_t*)p.out}; run_gemm(lds, (const bf16_t*)(ws + W_BUFA), (const bf16_t*)(ws + W_WA), MROWS, 1024, 1024, f); }
        else if (ph == 11) { FO f{(bf16_t*)p.out, (const bf16_t*)(ws + W_HBF)}; run_gemm(lds, (const bf16_t*)(ws + W_ZB4), (const bf16_t*)(ws + W_WO), MROWS, 1024, 1024, f);
            FP2 f2{(bf16_t*)(ws + W_OPS)}; run_gemm(lds, (const bf16_t*)(ws + W_PBF), (const bf16_t*)(ws + W_WP), MROWS, 1024, 256, f2, 16); }
        else if (ph == 12) ln1_phase(p);
        else if (ph == 13) { FG2 f{(bf16_t*)(ws + W_BUFB), (const bf16_t*)(ws + W_BUFA), (const bf16_t*)(ws + W_OPS)}; run_gemm(lds, (const bf16_t*)(ws + W_BUFA), (const bf16_t*)(ws + W_WG), MROWS, 1024, 1024, f); }
        else ln2_phase(p);
      }
        if (ph + 1 < p.ph_hi) { if (p.ph_hi > NPH) grid.sync(); else xcd_barrier(xb); }
        if (REP_PH == 100 && ph == 10) { for (int q = 0; q < 20; ++q) grid.sync(); }
    }
    if (DBG_SKIP && p.ph_hi == NPH) {
        const size_t i0 = (size_t)blockIdx.x * 512 + threadIdx.x, st = (size_t)gridDim.x * 512;
        for (size_t i = i0; i < O_CAP; i += st) p.out[i] = 0.f;
        if (DBG_SKIP == 1) { for (size_t i = i0; i < 262144; i += st) p.out[O_SP + i] = 0.f; for (size_t i = i0; i < 4194304; i += st) p.out[O_SS + i] = 0.f; }
        if (DBG_SKIP >= 3) { for (size_t i = i0; i < 262144; i += st) p.out[O_SP + i] = 0.f; }
    }
}

extern "C" void kernel_launch(void* const* d_in, const int* in_sizes, int n_in, void* d_out, int out_size, void* d_ws, size_t ws_size, hipStream_t stream) {
    static int grid = 0;
    if (grid == 0) {
        if (n_in != 24 || out_size != 39442432 || ws_size < W_END) { fprintf(stderr, "kernel_launch: unexpected shapes (n_in %d out %d ws %zu need %zu)\n", n_in, out_size, ws_size, (size_t)W_END); grid = -1; return; }
        int dev = 0, cus = 0, per_cu = 0;
        hipGetDevice(&dev); hipDeviceGetAttribute(&cus, hipDeviceAttributeMultiprocessorCount, dev);
        if (hipFuncSetAttribute((const void*)mk_fwd, hipFuncAttributeMaxDynamicSharedMemorySize, LDS_BYTES) != hipSuccess) { fprintf(stderr, "hipFuncSetAttribute failed\n"); grid = -1; return; }
        if (hipOccupancyMaxActiveBlocksPerMultiprocessor(&per_cu, (const void*)mk_fwd, 512, LDS_BYTES) != hipSuccess || per_cu < 1) { fprintf(stderr, "occupancy query failed (%d)\n", per_cu); grid = -1; return; }
        grid = cus * 1;
        fprintf(stderr, "kernel_launch: grid %d (per_cu %d), ws need %zu have %zu\n", grid, per_cu, (size_t)W_END, ws_size);
    }
    if (grid < 0) return;
    if (hipMemsetAsync((char*)d_ws + W_BAR, 0, 16384, stream) != hipSuccess) { fprintf(stderr, "kernel_launch: memset of barrier words failed\n"); return; }
    Params p{};
    for (int i = 0; i < 24; ++i) p.in[i] = (const float*)d_in[i];
    p.out = (float*)d_out; p.ws = (unsigned char*)d_ws;
#if MK_MULTI
    for (int ph = 0; ph < NPH; ++ph) { p.ph_lo = ph; p.ph_hi = ph + 1; hipLaunchKernelGGL(mk_fwd, dim3(grid), dim3(512), LDS_BYTES, stream, p); }
#else
    p.ph_lo = 0; p.ph_hi = NPH;
    void* args[] = {&p};
    hipError_t e = hipLaunchCooperativeKernel((void*)mk_fwd, dim3(grid), dim3(512), args, LDS_BYTES, stream);
    if (e != hipSuccess) fprintf(stderr, "cooperative launch failed: %s (grid %d)\n", hipGetErrorString(e), grid);
#endif
}
```

```cpp
#include <hip/hip_runtime.h>
#include <hip/hip_cooperative_groups.h>
#include <cstdio>
namespace cg = cooperative_groups;

#ifndef DBG_SKIP
#define DBG_SKIP 0
#endif
#ifndef REP_PH
#define REP_PH -1
#endif
#ifndef REP_N
#define REP_N 1
#endif
#ifndef MK_MULTI
#define MK_MULTI 0
#endif

#define LAS __attribute__((address_space(3)))
typedef unsigned short bf16_t;
typedef short bf16x8 __attribute__((ext_vector_type(8)));
typedef float f32x4 __attribute__((ext_vector_type(4)));
typedef unsigned u32x4 __attribute__((ext_vector_type(4)));
typedef unsigned u32x2 __attribute__((ext_vector_type(2)));

constexpr int MROWS = 33792, SEGM = 8448, NSEG = 4, DM = 1024, NZ = 10496, PD = 256;
constexpr float ALPHA_C = 1.189207115002721f;
constexpr int NPH = 15;
constexpr int LDS_BYTES = 131072 + 16;
constexpr size_t O_Y = 0, O_CAP = 34603008, O_SP = 34621440, O_CBP = 34883584, O_CAS = 34887680, O_SS = 35182592, O_CBS = 39376896;
constexpr size_t W_WIN = 0;
constexpr size_t W_WA = W_WIN + (size_t)NZ * 1024 * 2;
constexpr size_t W_WB = W_WA + 2097152, W_WO = W_WB + 2097152, W_WG = W_WO + 2097152;
constexpr size_t W_WP = W_WG + 2097152;
constexpr size_t W_PBF = W_WP + 524288;
constexpr size_t W_HBF = W_PBF + (size_t)MROWS * 256 * 2;
constexpr size_t W_BUFA = W_HBF + (size_t)MROWS * 2048;
constexpr size_t W_BUFB = W_BUFA + (size_t)MROWS * 2048;
constexpr size_t W_ZQ = W_BUFB + (size_t)MROWS * 2048;
constexpr size_t W_ZB4 = W_ZQ + (size_t)SEGM * 3072 * 2;
constexpr size_t W_BD = W_ZB4 + (size_t)SEGM * 4096 * 2;
constexpr size_t W_OPS = W_BD + (size_t)SEGM * 64;
constexpr size_t OPS_ITEM = 73728;
constexpr size_t W_GL = W_OPS + 1088 * OPS_ITEM;
constexpr size_t W_OSEG = W_GL + 8192;
constexpr size_t W_HISTA = W_OSEG + (size_t)SEGM * 2048;
constexpr size_t W_HISTB = W_HISTA + 5 * 2 * 3 * 3072 * 4;
constexpr size_t W_BAR = W_HISTB + 5 * 2 * 2 * 1024 * 4;
constexpr size_t W_END = W_BAR + 16384;

struct Params { const float* in[24]; float* out; unsigned char* ws; int ph_lo, ph_hi; };

typedef __bf16 bf16x2_t __attribute__((ext_vector_type(2)));
typedef float f32x2_t __attribute__((ext_vector_type(2)));
__device__ __forceinline__ unsigned cvt_pk_bf16(float lo, float hi) { f32x2_t v = {lo, hi}; bf16x2_t b = __builtin_convertvector(v, bf16x2_t); return __builtin_bit_cast(unsigned, b); }
__device__ __forceinline__ float bf_lo(unsigned u) { return __uint_as_float(u << 16); }
__device__ __forceinline__ float bf_hi(unsigned u) { return __uint_as_float(u & 0xffff0000u); }
__device__ __forceinline__ float sigmoidf_(float x) { return __builtin_amdgcn_rcpf(1.0f + __expf(-x)); }
__device__ __forceinline__ float siluf_(float x) { return x * __builtin_amdgcn_rcpf(1.0f + __expf(-x)); }
__device__ __forceinline__ int opaque_tid() { int t = threadIdx.x; asm volatile("" : "+v"(t)); return t; }
__device__ __forceinline__ void lds_barrier() { asm volatile("s_waitcnt lgkmcnt(0)" ::: "memory"); __builtin_amdgcn_s_barrier(); asm volatile("" ::: "memory"); }
__device__ __forceinline__ float wave_sum(float v) {
#pragma unroll
    for (int m = 32; m >= 1; m >>= 1) v += __shfl_xor(v, m);
    return v;
}
__device__ __forceinline__ int row2tok(int r) { const int s = r / SEGM, l = r - s * SEGM; if (l < 4096) return 4096 * s + l; if (l < 8192) return 16384 + 4096 * s + (l - 4096); return 32768 + 256 * s + (l - 8192); }
__device__ __forceinline__ void unpack8(const u32x4 v, float* f) { f[0] = bf_lo(v.x); f[1] = bf_hi(v.x); f[2] = bf_lo(v.y); f[3] = bf_hi(v.y); f[4] = bf_lo(v.z); f[5] = bf_hi(v.z); f[6] = bf_lo(v.w); f[7] = bf_hi(v.w); }
__device__ __forceinline__ u32x4 pack8(const float* f) { u32x4 w; w.x = cvt_pk_bf16(f[0], f[1]); w.y = cvt_pk_bf16(f[2], f[3]); w.z = cvt_pk_bf16(f[4], f[5]); w.w = cvt_pk_bf16(f[6], f[7]); return w; }

namespace pg8 {
constexpr int BM = 256, BK = 64, HALF = 128, HTB = HALF * BK * 2, STAGE_BYTES = 8 * HTB, NXCD = 8, WGM = 8;
__host__ __device__ __forceinline__ int lds_byte(int r, int c) { const int st = (r >> 4) * 2 + (c >> 5), rr = r & 15, cc = c & 31, ob = rr * 64 + cc * 2; return st * 1024 + (ob ^ (((ob >> 9) & 1) << 5)); }
__host__ __device__ __forceinline__ void stage_rc(int b, int& R, int& C) { const int st = b / 1024, sb = b % 1024, swz = sb ^ (((sb >> 9) & 1) << 5); R = (st >> 1) * 16 + swz / 64; C = (st & 1) * 32 + (swz % 64) / 2; }
__host__ __device__ __forceinline__ int perm32(int rho) { const int n = rho >> 4, i = rho & 15; return 8 * (i >> 2) + 4 * n + (i & 3); }
struct Unit { int pm, pn; };
struct Gemm { const bf16_t* A; const bf16_t* Bt; int M, N, K; };
struct StaticOrder {
    int nM, nN, nwg, G, c;
    __host__ __device__ void init(int M, int N, int G_, int c_) { nM = M / BM; nN = N / BM; nwg = nM * nN; G = G_; c = c_; }
    __host__ __device__ bool next(int i, Unit& u) const {
        const long L = (long)i * G + c; if (L >= nwg) return false;
        int wgid = (int)L; { const int q = nwg / NXCD, r = nwg % NXCD, xcd = wgid % NXCD, off = wgid / NXCD; wgid = (xcd < r ? xcd * (q + 1) : r * (q + 1) + (xcd - r) * q) + off; }
        const int nig = WGM * nN, gid = wgid / nig, fm = gid * WGM, gsz = (nM - fm) < WGM ? (nM - fm) : WGM;
        u.pm = fm + ((wgid % nig) % gsz); u.pn = (wgid % nig) / gsz; return true;
    }
    __device__ __forceinline__ void a_ready(const Unit&) const {}
    __device__ __forceinline__ void done(const Unit&) const {}
};

template <class Epi, class Sched>
__device__ __forceinline__ void gemm_phase(LAS unsigned char* lds, const Gemm g, const Sched& S, const Epi& E) {
    const int tid = opaque_tid(), wid = __builtin_amdgcn_readfirstlane(tid >> 6), lane = tid & 63, wr = wid >> 2, wc = wid & 3, fr = lane & 15, fq = lane >> 4;
    const int K = g.K, nt = K / BK;
    unsigned voffA[2], voffB[2];
#pragma unroll
    for (int i = 0; i < 2; ++i) { int R, C; stage_rc(tid * 16 + i * 8192, R, C); const int Rb = ((R & ~31) + perm32(R & 31));
        voffA[i] = (unsigned)(R * K + C) * 2u; voffB[i] = (unsigned)(Rb * K + C) * 2u; }
    const size_t kstep = (size_t)(BK * 2);
    const size_t hstep = (size_t)HALF * K * 2;
    const size_t tstep = 2 * hstep;
    const unsigned ldsw = (unsigned)wid * 1024u;
    const int aoff = lds_byte(wr * 64 + fr, fq * 8), boff = lds_byte(wc * 32 + fr, fq * 8);
#define PG8_SA(b, h) (((b) * 2 + (h)) * HTB)
#define PG8_SB(b, h) ((4 + (b) * 2 + (h)) * HTB)
#define PG8_STAGE(bufoff, gbase, voff) do { _Pragma("unroll") for (int _i = 0; _i < 2; ++_i) \
        __builtin_amdgcn_global_load_lds((const unsigned*)((const char*)(gbase) + (voff)[_i]), (LAS unsigned*)(lds + (bufoff) + ldsw + _i * 8192), 16, 0, 0); } while (0)
#define PG8_LDA(dst, b, h) do { _Pragma("unroll") for (int m = 0; m < 4; ++m) _Pragma("unroll") for (int k = 0; k < 2; ++k) dst[m][k] = *(const LAS bf16x8*)(lds + PG8_SA(b, h) + aoff + m * 2048 + k * 1024); } while (0)
#define PG8_LDB(dst, b, h) do { _Pragma("unroll") for (int n = 0; n < 2; ++n) _Pragma("unroll") for (int k = 0; k < 2; ++k) dst[n][k] = *(const LAS bf16x8*)(lds + PG8_SB(b, h) + boff + n * 2048 + k * 1024); } while (0)
#define PG8_MMA(ai, bj, At, Bt) do { __builtin_amdgcn_s_setprio(1); _Pragma("unroll") for (int m = 0; m < 4; ++m) _Pragma("unroll") for (int n = 0; n < 2; ++n) _Pragma("unroll") for (int k = 0; k < 2; ++k) \
        acc[ai][bj][m][n] = __builtin_amdgcn_mfma_f32_16x16x32_bf16(Bt[n][k], At[m][k], acc[ai][bj][m][n], 0, 0, 0); __builtin_amdgcn_s_setprio(0); } while (0)
#define PG8_WAIT_V(n) asm volatile("s_waitcnt vmcnt(" #n ")" ::: "memory")
#define PG8_WAIT_L(n) asm volatile("s_waitcnt lgkmcnt(" #n ")" ::: "memory")
#define PG8_BAR __builtin_amdgcn_s_barrier()
#define PG8_SCHED __builtin_amdgcn_sched_barrier(0)
    Unit cur, nxt; int ui = 0;
    if (!S.next(0, cur)) return;
    f32x4 acc[2][2][4][2];
#pragma unroll
    for (int a = 0; a < 2; ++a)
#pragma unroll
        for (int b = 0; b < 2; ++b)
#pragma unroll
            for (int m = 0; m < 4; ++m)
#pragma unroll
                for (int n = 0; n < 2; ++n) acc[a][b][m][n] = (f32x4){0.f, 0.f, 0.f, 0.f};
    bf16x8 At[4][2], B0[2][2], B1[2][2];
    const char* cA = (const char*)g.A + (size_t)cur.pm * tstep; const char* cB = (const char*)g.Bt + (size_t)cur.pn * tstep;
    S.a_ready(cur);
    PG8_STAGE(PG8_SB(0, 0), cB, voffB); PG8_STAGE(PG8_SA(0, 0), cA, voffA); PG8_STAGE(PG8_SB(0, 1), cB + hstep, voffB); PG8_STAGE(PG8_SA(0, 1), cA + hstep, voffA);
    if (wr == 1) PG8_BAR;
    PG8_WAIT_V(4); PG8_BAR;
    PG8_STAGE(PG8_SB(1, 0), cB + kstep, voffB); PG8_STAGE(PG8_SA(1, 0), cA + kstep, voffA); PG8_STAGE(PG8_SB(1, 1), cB + hstep + kstep, voffB);
    PG8_WAIT_V(6); PG8_BAR;
    for (;;) {
        const bool has_next = S.next(ui + 1, nxt);
        const char* nA = has_next ? (const char*)g.A + (size_t)nxt.pm * tstep : cA; const char* nB = has_next ? (const char*)g.Bt + (size_t)nxt.pn * tstep : cB;
#pragma unroll 1
        for (int t = 0; t < nt; t += 2) {
            const bool last = (t == nt - 2);
            const char* a1 = cA + (size_t)(t + 1) * kstep;
            const char* a2 = last ? nA : cA + (size_t)(t + 2) * kstep; const char* b2 = last ? nB : cB + (size_t)(t + 2) * kstep;
            const char* a3 = a2 + kstep; const char* b3 = b2 + kstep;
            if (last && has_next) S.a_ready(nxt);
            PG8_LDB(B0, 0, 0); PG8_SCHED; PG8_LDA(At, 0, 0); PG8_STAGE(PG8_SA(1, 1), a1 + hstep, voffA);
            PG8_WAIT_L(8); PG8_BAR; PG8_WAIT_L(0); PG8_MMA(0, 0, At, B0); PG8_BAR; PG8_SCHED;
            PG8_LDB(B1, 0, 1); PG8_STAGE(PG8_SB(0, 0), b2, voffB);
            PG8_BAR; PG8_WAIT_L(0); PG8_MMA(0, 1, At, B1); PG8_BAR;
            PG8_LDA(At, 0, 1); PG8_STAGE(PG8_SA(0, 0), a2, voffA);
            PG8_BAR; PG8_WAIT_L(0); PG8_MMA(1, 0, At, B0); PG8_BAR; PG8_SCHED;
            PG8_STAGE(PG8_SB(0, 1), b2 + hstep, voffB);
            PG8_WAIT_V(6); PG8_BAR; PG8_MMA(1, 1, At, B1); PG8_BAR;
            PG8_LDB(B0, 1, 0); PG8_SCHED; PG8_LDA(At, 1, 0); PG8_STAGE(PG8_SA(0, 1), a2 + hstep, voffA);
            PG8_WAIT_L(8); PG8_BAR; PG8_WAIT_L(0); PG8_MMA(0, 0, At, B0); PG8_BAR; PG8_SCHED;
            PG8_LDB(B1, 1, 1); PG8_STAGE(PG8_SB(1, 0), b3, voffB);
            PG8_BAR; PG8_WAIT_L(0); PG8_MMA(0, 1, At, B1); PG8_BAR;
            PG8_LDA(At, 1, 1); PG8_STAGE(PG8_SA(1, 0), a3, voffA);
            PG8_BAR; PG8_WAIT_L(0); PG8_MMA(1, 0, At, B0); PG8_BAR; PG8_SCHED;
            PG8_STAGE(PG8_SB(1, 1), b3 + hstep, voffB);
            PG8_WAIT_V(6); PG8_BAR; PG8_MMA(1, 1, At, B1); PG8_BAR;
        }
        E(acc, cur, wr, wc, fr, fq); S.done(cur);
        if (!has_next) break;
#pragma unroll
        for (int a = 0; a < 2; ++a)
#pragma unroll
            for (int b = 0; b < 2; ++b)
#pragma unroll
                for (int m = 0; m < 4; ++m)
#pragma unroll
                    for (int n = 0; n < 2; ++n) acc[a][b][m][n] = (f32x4){0.f, 0.f, 0.f, 0.f};
        cur = nxt; cA = nA; cB = nB; ++ui;
    }
    PG8_WAIT_V(0);
    if (wr == 0) PG8_BAR;
    PG8_BAR;
#undef PG8_SA
#undef PG8_SB
#undef PG8_STAGE
#undef PG8_LDA
#undef PG8_LDB
#undef PG8_MMA
#undef PG8_WAIT_V
#undef PG8_WAIT_L
#undef PG8_BAR
#undef PG8_SCHED
}
}

template <class F> struct EpiT {
    F f;
    __device__ __forceinline__ void operator()(const f32x4 (&acc)[2][2][4][2], const pg8::Unit& u, int wr, int wc, int fr, int fq) const {
        const int row0 = u.pm * 256 + wr * 64 + fr, col0 = u.pn * 256 + wc * 32 + 8 * fq;
        if constexpr (F::HAS_LOAD) {
            constexpr int PD = 4;
            typename F::LT buf[PD];
#pragma unroll
            for (int k = 0; k < PD; ++k) buf[k] = f.load(row0 + (k >> 3) * 128 + ((k >> 1) & 3) * 16, col0 + (k & 1) * 128);
#pragma unroll
            for (int idx = 0; idx < 16; ++idx) {
                const int ai = idx >> 3, m = (idx >> 1) & 3, bj = idx & 1;
                const typename F::LT cur = buf[idx % PD];
                if (idx + PD < 16) { const int i2 = idx + PD; buf[idx % PD] = f.load(row0 + (i2 >> 3) * 128 + ((i2 >> 1) & 3) * 16, col0 + (i2 & 1) * 128); }
                f.apply(row0 + ai * 128 + m * 16, col0 + bj * 128, acc[ai][bj][m][0], acc[ai][bj][m][1], cur); asm volatile("" ::: "memory");
            }
            return;
        }
#pragma unroll
        for (int ai = 0; ai < 2; ++ai)
#pragma unroll
            for (int m = 0; m < 4; ++m)
            {
                if constexpr (F::HAS_LOAD) { (void)ai; (void)m; break; }
                if constexpr (F::HAS_PAIR) { if (f.is_pair(u.pn)) { f.pair(row0 + ai * 128 + m * 16, col0, acc[ai][0][m][0], acc[ai][0][m][1], acc[ai][1][m][0], acc[ai][1][m][1]); asm volatile("" ::: "memory"); continue; } }
#pragma unroll
                for (int bj = 0; bj < 2; ++bj) { f(row0 + ai * 128 + m * 16, col0 + bj * 128, acc[ai][bj][m][0], acc[ai][bj][m][1]); asm volatile("" ::: "memory"); }
            }
    }
};
__device__ __forceinline__ u32x4 pack_v(const f32x4 v0, const f32x4 v1) { u32x4 w; w.x = cvt_pk_bf16(v0[0], v0[1]); w.y = cvt_pk_bf16(v0[2], v0[3]); w.z = cvt_pk_bf16(v1[0], v1[1]); w.w = cvt_pk_bf16(v1[2], v1[3]); return w; }

struct F1 {
    static constexpr bool HAS_LOAD = false;
    static constexpr bool HAS_PAIR = true;
    bf16_t* zq; bf16_t* za; bf16_t* zb4; bf16_t* gates; float* bd; int seg;
    __device__ __forceinline__ bool is_pair(int pn) const { return pn >= 16 && pn < 32; }
    __device__ __forceinline__ void pair(int row, int col, const f32x4 a0, const f32x4 a1, const f32x4 b0, const f32x4 b1) const {
        const int tt = (col - 4096) >> 8, ch = (tt & 7) * 128 + ((col - 4096) & 255); float o[8];
        if (tt < 8) {
#pragma unroll
            for (int j = 0; j < 4; ++j) { o[j] = a0[j] * b0[j]; o[4 + j] = a1[j] * b1[j]; }
            __builtin_nontemporal_store(pack8(o), (u32x4*)(zb4 + (size_t)row * 2048 + ch));
        } else {
#pragma unroll
            for (int j = 0; j < 4; ++j) { o[j] = a0[j] * siluf_(b0[j]); o[4 + j] = a1[j] * siluf_(b1[j]); }
            __builtin_nontemporal_store(pack8(o), (u32x4*)(zb4 + (size_t)row * 2048 + 1024 + ch));
        }
    }
    __device__ __forceinline__ void operator()(int row, int col, const f32x4 v0, const f32x4 v1) const {
        const size_t R = (size_t)seg * SEGM + row;
        if (col < 3072) __builtin_nontemporal_store(pack_v(v0, v1), (u32x4*)(zq + (size_t)row * 3072 + col));
        else if (col < 4096) __builtin_nontemporal_store(pack_v(v0, v1), (u32x4*)(za + R * 1024 + (col - 3072)));
        else if (col >= 8192 && col < 10240) __builtin_nontemporal_store(pack_v(v0, v1), (u32x4*)(gates + R * 2048 + (col - 8192)));
        else if (col >= 10240 && col < 10256) { float* d = bd + (size_t)row * 16 + (col - 10240); *(f32x4*)d = v0; *(f32x4*)(d + 4) = v1; }
    }
};
struct FB {
    static constexpr bool HAS_PAIR = false, HAS_LOAD = true;
    typedef u32x4 LT;
    bf16_t* mb; const bf16_t* gates;
    __device__ __forceinline__ LT load(int row, int col) const { return __builtin_nontemporal_load((const u32x4*)(gates + (size_t)row * 2048 + 1024 + col)); }
    __device__ __forceinline__ void apply(int row, int col, const f32x4 v0, const f32x4 v1, const LT& l) const {
        float gt[8]; unpack8(l, gt); float o[8];
#pragma unroll
        for (int j = 0; j < 4; ++j) { o[j] = sigmoidf_(gt[j]) * v0[j]; o[4 + j] = sigmoidf_(gt[4 + j]) * v1[j]; }
        *(u32x4*)(mb + (size_t)row * 1024 + col) = pack8(o);
    }
    __device__ __forceinline__ void operator()(int, int, const f32x4, const f32x4) const {}
};
struct FA {
    static constexpr bool HAS_PAIR = false, HAS_LOAD = true;
    struct LT { u32x4 g, m; };
    bf16_t* mb; const bf16_t* gates;
    __device__ __forceinline__ LT load(int row, int col) const { LT l; l.g = __builtin_nontemporal_load((const u32x4*)(gates + (size_t)row * 2048 + col)); l.m = __builtin_nontemporal_load((const u32x4*)(mb + (size_t)row * 1024 + col)); return l; }
    __device__ __forceinline__ void apply(int row, int col, const f32x4 v0, const f32x4 v1, const LT& l) const {
        float gt[8], pm[8]; unpack8(l.g, gt); unpack8(l.m, pm); float o[8];
#pragma unroll
        for (int j = 0; j < 4; ++j) { o[j] = sigmoidf_(gt[j]) * v0[j] + pm[j]; o[4 + j] = sigmoidf_(gt[4 + j]) * v1[j] + pm[4 + j]; }
        *(u32x4*)(mb + (size_t)row * 1024 + col) = pack8(o);
    }
    __device__ __forceinline__ void operator()(int, int, const f32x4, const f32x4) const {}
};
struct FO {
    static constexpr bool HAS_PAIR = false, HAS_LOAD = true;
    typedef u32x4 LT;
    bf16_t* pre; const bf16_t* hbf;
    __device__ __forceinline__ LT load(int row, int col) const { return __builtin_nontemporal_load((const u32x4*)(hbf + (size_t)row * 1024 + col)); }
    __device__ __forceinline__ void apply(int row, int col, const f32x4 v0, const f32x4 v1, const LT& l) const {
        float hv[8]; unpack8(l, hv); f32x4 a, b;
#pragma unroll
        for (int j = 0; j < 4; ++j) { a[j] = ALPHA_C * hv[j] + v0[j]; b[j] = ALPHA_C * hv[4 + j] + v1[j]; }
        *(u32x4*)(pre + (size_t)row * 1024 + col) = pack_v(a, b);
    }
    __device__ __forceinline__ void operator()(int, int, const f32x4, const f32x4) const {}
};
struct FG {
    static constexpr bool HAS_LOAD = false;
    static constexpr bool HAS_PAIR = false;
    bf16_t* gb;
    __device__ __forceinline__ void operator()(int row, int col, const f32x4 v0, const f32x4 v1) const {
        float o[8];
#pragma unroll
        for (int j = 0; j < 4; ++j) { o[j] = sigmoidf_(v0[j]); o[4 + j] = sigmoidf_(v1[j]); }
        *(u32x4*)(gb + (size_t)row * 1024 + col) = pack8(o);
    }
};
struct FP {
    static constexpr bool HAS_LOAD = false;
    static constexpr bool HAS_PAIR = false;
    float* out; const bf16_t* h1; const bf16_t* gb;
    __device__ __forceinline__ void operator()(int row, int col, const f32x4 v0, const f32x4 v1) const {
        float hv[8], gv[8]; unpack8(*(const u32x4*)(h1 + (size_t)row * 1024 + col), hv); unpack8(*(const u32x4*)(gb + (size_t)row * 1024 + col), gv); f32x4 a, b;
#pragma unroll
        for (int j = 0; j < 4; ++j) { a[j] = ALPHA_C * hv[j] + gv[j] * v0[j]; b[j] = ALPHA_C * hv[4 + j] + gv[4 + j] * v1[j]; }
        float* d = out + (size_t)row2tok(row) * 1024 + col; *(f32x4*)d = a; *(f32x4*)(d + 4) = b;
    }
};
struct FP2 {
    static constexpr bool HAS_LOAD = false;
    static constexpr bool HAS_PAIR = false;
    bf16_t* pb;
    __device__ __forceinline__ void operator()(int row, int col, const f32x4 v0, const f32x4 v1) const { *(u32x4*)(pb + (size_t)row * 1024 + col) = pack_v(v0, v1); }
};
struct FG2 {
    static constexpr bool HAS_PAIR = false, HAS_LOAD = true;
    struct LT { u32x4 h, pb; };
    bf16_t* out; const bf16_t* h1; const bf16_t* pb;
    __device__ __forceinline__ LT load(int row, int col) const { LT l; l.h = __builtin_nontemporal_load((const u32x4*)(h1 + (size_t)row * 1024 + col)); l.pb = __builtin_nontemporal_load((const u32x4*)(pb + (size_t)row * 1024 + col)); return l; }
    __device__ __forceinline__ void apply(int row, int col, const f32x4 v0, const f32x4 v1, const LT& l) const {
        float hv[8], pv[8]; unpack8(l.h, hv); unpack8(l.pb, pv); f32x4 a, b;
#pragma unroll
        for (int j = 0; j < 4; ++j) { a[j] = ALPHA_C * hv[j] + sigmoidf_(v0[j]) * pv[j]; b[j] = ALPHA_C * hv[4 + j] + sigmoidf_(v1[j]) * pv[4 + j]; }
        *(u32x4*)(out + (size_t)row * 1024 + col) = pack_v(a, b);
    }
    __device__ __forceinline__ void operator()(int, int, const f32x4, const f32x4) const {}
};
template <class F> __device__ __forceinline__ void run_gemm(LAS unsigned char* lds, const bf16_t* A, const bf16_t* Bt, int M, int N, int K, const F& f, int skip = 0) {
    if ((int)blockIdx.x < skip) return;
    pg8::Gemm g{A, Bt, M, N, K}; pg8::StaticOrder S; S.init(M, N, (int)gridDim.x - skip, (int)blockIdx.x - skip); EpiT<F> E{f};
    pg8::gemm_phase<EpiT<F>, pg8::StaticOrder>(lds, g, S, E);
}

__device__ __forceinline__ void ln_row(const float* x, const float* gw, const float* bw, int lane, float (&o)[16]) {
    f32x4 v[4];
#pragma unroll
    for (int k = 0; k < 4; ++k) v[k] = *(const f32x4*)(x + 4 * lane + 256 * k);
    float s = 0.f;
#pragma unroll
    for (int k = 0; k < 4; ++k) s += (v[k][0] + v[k][1]) + (v[k][2] + v[k][3]);
    const float mu = wave_sum(s) * (1.0f / 1024.0f);
    float q = 0.f;
#pragma unroll
    for (int k = 0; k < 4; ++k) { const f32x4 d = v[k] - mu; q += (d[0] * d[0] + d[1] * d[1]) + (d[2] * d[2] + d[3] * d[3]); }
    const float rstd = rsqrtf(wave_sum(q) * (1.0f / 1024.0f) + 1e-5f);
#pragma unroll
    for (int k = 0; k < 4; ++k) { const f32x4 gg = *(const f32x4*)(gw + 4 * lane + 256 * k), bb = *(const f32x4*)(bw + 4 * lane + 256 * k);
#pragma unroll
        for (int j = 0; j < 4; ++j) o[4 * k + j] = (v[k][j] - mu) * rstd * gg[j] + bb[j]; }
}
__device__ __forceinline__ void ln_row_bf16in(const bf16_t* x, const float* gw, const float* bw, int lane, float (&o)[16]) {
    f32x4 v[4];
#pragma unroll
    for (int k = 0; k < 4; ++k) { const u32x2 u = *(const u32x2*)(x + 4 * lane + 256 * k); v[k] = (f32x4){bf_lo(u.x), bf_hi(u.x), bf_lo(u.y), bf_hi(u.y)}; }
    float s = 0.f;
#pragma unroll
    for (int k = 0; k < 4; ++k) s += (v[k][0] + v[k][1]) + (v[k][2] + v[k][3]);
    const float mu = wave_sum(s) * (1.0f / 1024.0f);
    float q = 0.f;
#pragma unroll
    for (int k = 0; k < 4; ++k) { const f32x4 d = v[k] - mu; q += (d[0] * d[0] + d[1] * d[1]) + (d[2] * d[2] + d[3] * d[3]); }
    const float rstd = rsqrtf(wave_sum(q) * (1.0f / 1024.0f) + 1e-5f);
#pragma unroll
    for (int k = 0; k < 4; ++k) { const f32x4 gg = *(const f32x4*)(gw + 4 * lane + 256 * k), bb = *(const f32x4*)(bw + 4 * lane + 256 * k);
#pragma unroll
        for (int j = 0; j < 4; ++j) o[4 * k + j] = (v[k][j] - mu) * rstd * gg[j] + bb[j]; }
}
__device__ __forceinline__ void store_row_bf16(bf16_t* dst, int lane, const float (&o)[16]) {
#pragma unroll
    for (int k = 0; k < 4; ++k) { u32x2 w; w.x = cvt_pk_bf16(o[4 * k], o[4 * k + 1]); w.y = cvt_pk_bf16(o[4 * k + 2], o[4 * k + 3]); *(u32x2*)(dst + 4 * lane + 256 * k) = w; }
}
__device__ __forceinline__ void cvtT(const float* src, int K, int Nsrc, bf16_t* dst, int Ndst, int mode, int gw, int nW, int lane) {
    const int nbn = Ndst / 64, nit = nbn * (K / 8);
    for (int it = gw; it < nit; it += nW) {
        const int nb = it % nbn, kb = it / nbn, n = nb * 64 + lane, k0 = kb * 8;
        int col = n;
        if (mode == 1) {
            if (n < 4096) col = n;
            else if (n < 8192) { const int tt = (n - 4096) >> 8, w = (n - 4096) & 255, hf = w >> 7, ch = (tt & 7) * 128 + (w & 127);
                col = tt < 8 ? (hf == 0 ? 5136 + ch : 6160 + ch) : (hf == 0 ? 4112 + ch : 7184 + ch); }
            else col = n < 10240 ? n + 16 : (n < 10256 ? 4096 + (n - 10240) : -1);
        }
        float f[8];
#pragma unroll
        for (int j = 0; j < 8; ++j) f[j] = col >= 0 ? src[(size_t)(k0 + j) * Nsrc + col] : 0.f;
        *(u32x4*)(dst + (size_t)n * K + k0) = pack8(f);
    }
}
__device__ void ln_in_rows(const Params& p, int r_lo, int r_hi, int gw, int nW, int lane) {
    bf16_t* hbf = (bf16_t*)(p.ws + W_HBF); bf16_t* pbf = (bf16_t*)(p.ws + W_PBF);
    for (int r = r_lo + gw; r < r_hi; r += nW) {
        const int t = row2tok(r);
        const float* x = t < 32768 ? p.in[0] + (size_t)t * 1024 : p.in[1] + (size_t)(t - 32768) * 1024;
        const float* pp = t < 32768 ? p.in[5] + (size_t)t * 256 : p.in[6] + (size_t)(t - 32768) * 256;
        float o[16]; ln_row(x, p.in[7], p.in[8], lane, o); store_row_bf16(hbf + (size_t)r * 1024, lane, o);
        const f32x4 pv = *(const f32x4*)(pp + 4 * lane); u32x2 w; w.x = cvt_pk_bf16(pv[0], pv[1]); w.y = cvt_pk_bf16(pv[2], pv[3]); *(u32x2*)(pbf + (size_t)r * 256 + 4 * lane) = w;
    }
}
__device__ void cvt_small_weights(const Params& p, int gw, int nW, int lane) {
    cvtT(p.in[15], 1024, 1024, (bf16_t*)(p.ws + W_WA), 1024, 0, gw, nW, lane);
    cvtT(p.in[16], 1024, 1024, (bf16_t*)(p.ws + W_WB), 1024, 0, gw, nW, lane);
    cvtT(p.in[17], 1024, 1024, (bf16_t*)(p.ws + W_WO), 1024, 0, gw, nW, lane);
    cvtT(p.in[21], 1024, 1024, (bf16_t*)(p.ws + W_WG), 1024, 0, gw, nW, lane);
    cvtT(p.in[20], 256, 1024, (bf16_t*)(p.ws + W_WP), 1024, 0, gw, nW, lane);
}
__device__ void phase0(const Params& p) {
    const int tid = opaque_tid(), lane = tid & 63, wid = tid >> 6, gw = blockIdx.x * 8 + wid, nW = gridDim.x * 8;
    ln_in_rows(p, 0, SEGM, gw, nW, lane);
    cvtT(p.in[9], 1024, 10256, (bf16_t*)(p.ws + W_WIN), NZ, 1, gw, nW, lane);
    float* ha = (float*)(p.ws + W_HISTA); float* hb = (float*)(p.ws + W_HISTB);
    for (int i = blockIdx.x * 512 + tid; i < 2 * 3 * 3072; i += gridDim.x * 512) ha[i] = 0.f;
    for (int i = blockIdx.x * 512 + tid; i < 2 * 2 * 1024; i += gridDim.x * 512) hb[i] = 0.f;
}

constexpr int P_KR = 0, P_QR = 17408, P_KT = 34816;
constexpr int H_VT = 0, H_AM = 18432, H_TU = 34816, H_TW = 44032, H_SC = 53248;
__device__ __forceinline__ bf16x8 fragR(LAS unsigned char* base, int row, int stride, int ks, int g) { return *(const LAS bf16x8*)(base + row * stride + (32 * ks + 8 * g) * 2); }
__device__ __forceinline__ float sel4(const f32x4 a, int i) { return i == 0 ? a[0] : (i == 1 ? a[1] : (i == 2 ? a[2] : a[3])); }

struct S1Regs { unsigned qpk[16], kpk[16], vT[2][8]; float be, gg; };
__device__ __forceinline__ void s1_compute(const Params& p, int seg, int item, int wq, int lane, S1Regs& R) {
    const int lc = item >> 3, h = item & 7;
    const bool prompt = lc < 128; const int b = lc >> 6, c = lc & 63;
    const int rowbase = prompt ? b * 4096 + c * 64 : 8192 + 32 * (lc - 128); const int nvalid = prompt ? 64 : 32;
    const bf16_t* zq = (const bf16_t*)(p.ws + W_ZQ);
    const float* hist = prompt ? (const float*)(p.ws + W_HISTA) + (size_t)(seg * 2 + b) * 9216 : p.in[2] + (size_t)(8 * seg + (lc - 128)) * 9216;
    const bool hist_from_z = prompt && c > 0;
    unsigned xr[3][19];
#pragma unroll
    for (int pt = 0; pt < 3; ++pt) {
        const int ch = pt * 1024 + h * 128 + 2 * lane;
#pragma unroll
        for (int jj = 0; jj < 19; ++jj) {
            const int tt = 16 * wq + jj - 3;
            if (tt >= 0 || hist_from_z) { const int ttc = tt < nvalid - 1 ? tt : nvalid - 1; xr[pt][jj] = *(const unsigned*)(zq + (size_t)(rowbase + ttc) * 3072 + ch); }
            else { const float* rp = hist + (size_t)(3 + tt) * 3072 + ch; xr[pt][jj] = cvt_pk_bf16(rp[0], rp[1]); }
        }
    }
#pragma unroll
    for (int pt = 0; pt < 3; ++pt) {
        const int ch = pt * 1024 + h * 128 + 2 * lane;
        float cw[4][2];
#pragma unroll
        for (int j = 0; j < 4; ++j) { cw[j][0] = p.in[10][j * 3072 + ch]; cw[j][1] = p.in[10][j * 3072 + ch + 1]; }
#pragma unroll
        for (int i2 = 0; i2 < 8; ++i2) {
            float y[2][2];
#pragma unroll
            for (int q = 0; q < 2; ++q) {
                const int i = 2 * i2 + q; const bool valid = (16 * wq + i) < nvalid;
                float a0 = bf_lo(xr[pt][i]) * cw[0][0], a1 = bf_hi(xr[pt][i]) * cw[0][1];
#pragma unroll
                for (int k = 1; k < 4; ++k) { a0 += bf_lo(xr[pt][i + k]) * cw[k][0]; a1 += bf_hi(xr[pt][i + k]) * cw[k][1]; }
                y[q][0] = valid ? siluf_(a0) : 0.f; y[q][1] = valid ? siluf_(a1) : 0.f;
            }
            if (pt == 0) { R.qpk[2 * i2] = cvt_pk_bf16(y[0][0], y[0][1]); R.qpk[2 * i2 + 1] = cvt_pk_bf16(y[1][0], y[1][1]); }
            else if (pt == 1) { R.kpk[2 * i2] = cvt_pk_bf16(y[0][0], y[0][1]); R.kpk[2 * i2 + 1] = cvt_pk_bf16(y[1][0], y[1][1]); }
            else { R.vT[0][i2] = cvt_pk_bf16(y[0][0], y[1][0]); R.vT[1][i2] = cvt_pk_bf16(y[0][1], y[1][1]); }
        }
    }
    if (wq == 0) {
        const float* bd = (const float*)(p.ws + W_BD);
        const int ic = lane < nvalid ? lane : nvalid - 1;
        const float bv = bd[(size_t)(rowbase + ic) * 16 + h], dv = bd[(size_t)(rowbase + ic) * 16 + 8 + h];
        const float xx = dv + p.in[12][h];
        const float sp = xx > 20.f ? xx : log1pf(__expf(xx));
        float gg = lane < nvalid ? -__expf(p.in[11][h]) * sp : 0.f;
        R.be = lane < nvalid ? sigmoidf_(bv) : 0.f;
#pragma unroll
        for (int d = 1; d < 64; d <<= 1) { const float t = __shfl_up(gg, d); if (lane >= d) gg += t; }
        R.gg = gg;
    }
}
__device__ __forceinline__ void s1_write(LAS unsigned char* lo, LAS unsigned char* hi, int wq, int lane, const S1Regs& R) {
#pragma unroll
    for (int i = 0; i < 16; ++i) { *(LAS unsigned*)(lo + P_QR + (16 * wq + i) * 272 + 4 * lane) = R.qpk[i]; *(LAS unsigned*)(lo + P_KR + (16 * wq + i) * 272 + 4 * lane) = R.kpk[i]; }
#pragma unroll
    for (int e = 0; e < 2; ++e)
#pragma unroll
        for (int hq = 0; hq < 2; ++hq) {
            u32x4 wk, wv;
#pragma unroll
            for (int j = 0; j < 4; ++j) { const unsigned a = R.kpk[8 * hq + 2 * j], b2 = R.kpk[8 * hq + 2 * j + 1];
                wk[j] = e == 0 ? ((a & 0xffffu) | (b2 << 16)) : ((a >> 16) | (b2 & 0xffff0000u)); wv[j] = R.vT[e][4 * hq + j]; }
            *(LAS u32x4*)(lo + P_KT + (2 * lane + e) * 144 + 32 * wq + 16 * hq) = wk;
            *(LAS u32x4*)(hi + H_VT + (2 * lane + e) * 144 + 32 * wq + 16 * hq) = wv;
        }
    if (wq == 0) { LAS float* SC = (LAS float*)(hi + H_SC); SC[lane] = R.be; SC[64 + lane] = R.gg; }
}
__device__ __forceinline__ void prep_item(const Params& p, int seg, int item, int next_item, S1Regs& R, LAS unsigned char* lds) {
    const int tid = opaque_tid(), lane = tid & 63, wid = __builtin_amdgcn_readfirstlane(tid >> 6), n = lane & 15, g = lane >> 4;
    const int lc = item >> 3, h = item & 7;
    unsigned char* ops = p.ws + W_OPS + (size_t)item * OPS_ITEM;
    LAS unsigned char* lo; LAS unsigned char* hi; { unsigned o0 = 0, o1 = 53248; asm volatile("" : "+v"(o0), "+v"(o1)); lo = lds + o0; hi = lds + o1; }
    LAS float* SC = (LAS float*)(hi + H_SC);
    if (wid >= 4) s1_write(lo, hi, wid - 4, lane, R);
    lds_barrier();
    const int it = wid >> 1, jh = wid & 1;
    f32x4 kka[2], qka[2];
    {
        bf16x8 ki[4], qi[4];
#pragma unroll
        for (int ks = 0; ks < 4; ++ks) { ki[ks] = fragR(lo + P_KR, 16 * it + n, 272, ks, g); qi[ks] = fragR(lo + P_QR, 16 * it + n, 272, ks, g); }
#pragma unroll
        for (int j2 = 0; j2 < 2; ++j2) {
            const int jt = 2 * jh + j2; f32x4 a = {0.f, 0.f, 0.f, 0.f}, q = {0.f, 0.f, 0.f, 0.f};
#pragma unroll
            for (int ks = 0; ks < 4; ++ks) { const bf16x8 kj = fragR(lo + P_KR, 16 * jt + n, 272, ks, g);
                a = __builtin_amdgcn_mfma_f32_16x16x32_bf16(ki[ks], kj, a, 0, 0, 0);
                q = __builtin_amdgcn_mfma_f32_16x16x32_bf16(kj, qi[ks], q, 0, 0, 0); }
            kka[j2] = a; qka[j2] = q;
        }
        f32x4 dg;
        const bool kdiag = (it >> 1) == jh;
        if (kdiag) dg = (it & 1) ? kka[1] : kka[0];
        else { dg = (f32x4){0.f, 0.f, 0.f, 0.f};
#pragma unroll
            for (int ks = 0; ks < 4; ++ks) dg = __builtin_amdgcn_mfma_f32_16x16x32_bf16(qi[ks], qi[ks], dg, 0, 0, 0); }
        const float dv = sel4(dg, n & 3);
        if (g == (n >> 2)) { if (kdiag) SC[192 + 16 * it + n] = rsqrtf(dv + 1e-6f); else SC[128 + 16 * it + n] = rsqrtf(dv + 1e-6f) * 0.08838834764831845f; }
    }
    lds_barrier();
    {
        bf16_t* qkg = (bf16_t*)(ops + 65536);
#pragma unroll
        for (int j2 = 0; j2 < 2; ++j2) {
            const int jt = 2 * jh + j2;
            { const int j = 16 * jt + n; const float rkj = SC[192 + j], gcj = SC[64 + j];
#pragma unroll
              for (int r = 0; r < 4; ++r) { const int i = 16 * it + 4 * g + r; const float df = SC[64 + i] - gcj;
                  const float v = (i > j) ? SC[i] * kka[j2][r] * SC[192 + i] * rkj * __expf(fminf(df, 0.f)) : 0.f;
                  *(LAS float*)(hi + H_AM + (i * 64 + j) * 4) = v; } }
            { const int i = 16 * it + n; const float rqi = SC[128 + i], gci = SC[64 + i]; float o[4];
#pragma unroll
              for (int r = 0; r < 4; ++r) { const int j = 16 * jt + 4 * g + r; const float df = gci - SC[64 + j];
                  o[r] = (i >= j) ? qka[j2][r] * rqi * SC[192 + j] * __expf(fminf(df, 0.f)) : 0.f; }
              u32x2 w; w.x = cvt_pk_bf16(o[0], o[1]); w.y = cvt_pk_bf16(o[2], o[3]);
              *(u32x2*)(qkg + i * 64 + 32 * (jt >> 1) + 8 * g + 4 * (jt & 1)) = w; }
        }
    }
    lds_barrier();
    if (wid < 4) {
        const LAS float* AM = (const LAS float*)(hi + H_AM);
        LAS float* TL; { unsigned o2 = 107520; asm volatile("" : "+v"(o2)); TL = (LAS float*)(lds + o2); }
        const int col = 16 * wid + n;
#pragma unroll 1
        for (int I = wid; I < 4; ++I) {
            float x[16];
            if (I > wid) {
                f32x4 acc = {0.f, 0.f, 0.f, 0.f};
#pragma unroll 1
                for (int J = wid; J < I; ++J) {
#pragma unroll
                    for (int ks = 0; ks < 4; ++ks)
                        acc = __builtin_amdgcn_mfma_f32_16x16x4f32(AM[(16 * I + n) * 64 + 16 * J + 4 * ks + g], TL[(16 * J + 4 * ks + g) * 64 + col], acc, 0, 0, 0);
                }
#pragma unroll
                for (int r = 0; r < 4; ++r) TL[(16 * I + 4 * g + r) * 64 + col] = -acc[r];
            }
#pragma unroll
            for (int r = 0; r < 16; ++r) { const float d = (16 * I + r) == col ? 1.f : 0.f; x[r] = I > wid ? TL[(16 * I + r) * 64 + col] + d : d; }
#pragma unroll
            for (int r = 1; r < 16; ++r) {
                f32x4 ar[4];
#pragma unroll
                for (int q = 0; q < (r + 3) / 4; ++q) ar[q] = *(const LAS f32x4*)(AM + (16 * I + r) * 64 + 16 * I + 4 * q);
                float s = x[r];
#pragma unroll
                for (int rp = 0; rp < r; ++rp) s -= ar[rp >> 2][rp & 3] * x[rp];
                x[r] = s;
            }
#pragma unroll
            for (int r = 0; r < 16; ++r) TL[(16 * I + r) * 64 + col] = x[r];
        }
        const float be = SC[col], sw = be * __expf(SC[64 + col]) * SC[192 + col];
        const bool zr = g < wid;
#pragma unroll 4
        for (int rr = 0; rr < 16; rr += 2) {
            const int i = 16 * g + rr;
            const float t0 = zr ? 0.f : TL[i * 64 + col], t1 = zr ? 0.f : TL[(i + 1) * 64 + col];
            const unsigned u = cvt_pk_bf16(t0 * be, t1 * be), w = cvt_pk_bf16(t0 * sw, t1 * sw);
            *(LAS bf16_t*)(hi + H_TU + i * 144 + 2 * col) = (bf16_t)(u & 0xffffu); *(LAS bf16_t*)(hi + H_TU + (i + 1) * 144 + 2 * col) = (bf16_t)(u >> 16);
            *(LAS bf16_t*)(hi + H_TW + i * 144 + 2 * col) = (bf16_t)(w & 0xffffu); *(LAS bf16_t*)(hi + H_TW + (i + 1) * 144 + 2 * col) = (bf16_t)(w >> 16);
        }
    } else {
        const float gcl = SC[64 + 63];
        for (int v = tid - 256; v < 2048; v += 256) {
            if (v < 1024) { const int i = v >> 4, c16 = v & 15; float f[8]; unpack8(*(const LAS u32x4*)(lo + P_QR + i * 272 + c16 * 16), f);
                const float s = SC[128 + i] * __expf(SC[64 + i]);
#pragma unroll
                for (int j = 0; j < 8; ++j) f[j] *= s;
                { const u32x4 pk = pack8(f); const int t = c16 >> 2, hf = (c16 >> 1) & 1, g1 = 2 * (c16 & 1);
                  bf16_t* dq = (bf16_t*)(ops + 16384) + i * 128 + 32 * t + 4 * hf;
                  *(u32x2*)(dq + 8 * g1) = (u32x2){pk.x, pk.y}; *(u32x2*)(dq + 8 * (g1 + 1)) = (u32x2){pk.z, pk.w}; }
            } else { const int vv = v - 1024, d = vv >> 3, c8 = vv & 7; float f[8]; unpack8(*(const LAS u32x4*)(lo + P_KT + d * 144 + c8 * 16), f);
#pragma unroll
                for (int j = 0; j < 8; ++j) { const int i = 8 * c8 + j; f[j] *= SC[192 + i] * __expf(gcl - SC[64 + i]); }
                { const u32x4 pk = pack8(f); const int t = c8 >> 2, hf = (c8 >> 1) & 1, g1 = 2 * (c8 & 1);
                  bf16_t* dk = (bf16_t*)(ops + 32768) + d * 64 + 32 * t + 4 * hf;
                  *(u32x2*)(dk + 8 * g1) = (u32x2){pk.x, pk.y}; *(u32x2*)(dk + 8 * (g1 + 1)) = (u32x2){pk.z, pk.w}; }
            }
        }
        if (tid == 256) ((float*)(p.ws + W_GL))[item] = __expf(gcl);
        if (next_item < 1088) s1_compute(p, seg, next_item, wid - 4, lane, R);
    }
    lds_barrier();
    {
        bf16x8 kt[2], vt[2];
#pragma unroll
        for (int ks = 0; ks < 2; ++ks) { kt[ks] = fragR(lo + P_KT, 16 * wid + n, 144, ks, g); vt[ks] = fragR(hi + H_VT, 16 * wid + n, 144, ks, g); }
        bf16_t* wg = (bf16_t*)ops; bf16_t* ug = (bf16_t*)(ops + 49152);
#pragma unroll
        for (int i4 = 0; i4 < 4; ++i4) {
            f32x4 wa = {0.f, 0.f, 0.f, 0.f}, ua = {0.f, 0.f, 0.f, 0.f};
#pragma unroll
            for (int ks = 0; ks < 2; ++ks) {
                wa = __builtin_amdgcn_mfma_f32_16x16x32_bf16(kt[ks], fragR(hi + (DBG_SKIP == 9 ? H_TU : H_TW), 16 * i4 + n, 144, ks, g), wa, 0, 0, 0);
                ua = __builtin_amdgcn_mfma_f32_16x16x32_bf16(fragR(hi + H_TU, 16 * i4 + n, 144, ks, g), vt[ks], ua, 0, 0, 0);
            }
            u32x2 w; w.x = cvt_pk_bf16(wa[0], wa[1]); w.y = cvt_pk_bf16(wa[2], wa[3]); *(u32x2*)(wg + (16 * i4 + n) * 128 + 32 * (wid >> 1) + 8 * g + 4 * (wid & 1)) = w;
            u32x2 u; u.x = cvt_pk_bf16(ua[0], ua[1]); u.y = cvt_pk_bf16(ua[2], ua[3]); *(u32x2*)(ug + (16 * wid + n) * 64 + 16 * i4 + 4 * g) = u;
        }
    }
    lds_barrier();
}

__device__ void yb_rows(const Params& p, int seg) {
    const int skipb = gridDim.x > 128 ? 64 : 0;
    if ((int)blockIdx.x < skipb) return;
    const int tid = opaque_tid(), lane = tid & 63, wid = tid >> 6, gw = ((int)blockIdx.x - skipb) * 8 + wid, nW = ((int)gridDim.x - skipb) * 8;
    const bf16_t* zb4 = (const bf16_t*)(p.ws + W_ZB4); const bf16_t* zq = (const bf16_t*)(p.ws + W_ZQ);
    bf16_t* yb = (bf16_t*)(p.ws + W_BUFB);
    for (int l = gw; l < SEGM; l += nW) {
        const size_t R = (size_t)seg * SEGM + l;
        const bool prompt = l < 8192; const int b = l >> 12, tl = prompt ? (l & 4095) : ((l - 8192) & 31), sq = 8 * seg + ((l - 8192) >> 5);
        const float* hb = prompt ? (const float*)(p.ws + W_HISTB) + (size_t)(seg * 2 + b) * 2048 : p.in[4] + (size_t)sq * 2048;
        const bf16_t* zr = zb4 + (size_t)l * 2048;
#pragma unroll
        for (int half = 0; half < 2; ++half) {
            const int c0 = 8 * lane + 512 * half;
            float cu[3][8];
#pragma unroll
            for (int k = 0; k < 3; ++k) {
                if (tl - k >= 0) { unpack8(*(const u32x4*)(zr - (size_t)k * 2048 + c0), cu[k]);
                } else { const float* hp = hb + (size_t)(2 + tl - k) * 1024 + c0;
#pragma unroll
                    for (int j = 0; j < 8; ++j) cu[k][j] = hp[j]; }
            }
            float bz[8], o[8]; unpack8(*(const u32x4*)(zr + 1024 + c0), bz);
#pragma unroll
            for (int j = 0; j < 8; ++j) { float cv = cu[2][j] * p.in[14][c0 + j]; cv += cu[1][j] * p.in[14][1024 + c0 + j]; cv += cu[0][j] * p.in[14][2048 + c0 + j]; o[j] = bz[j] * cv; }
            *(u32x4*)(yb + R * 1024 + c0) = pack8(o);
            if (prompt && tl >= 4094) { float* d = (float*)(p.ws + W_HISTB) + (size_t)((seg + 1) * 2 + b) * 2048 + (size_t)(tl - 4094) * 1024 + c0;
#pragma unroll
                for (int j = 0; j < 8; ++j) d[j] = cu[0][j];
                if (seg == NSEG - 1) { float* d2 = p.out + O_CBP + (size_t)b * 2048 + (size_t)(tl - 4094) * 1024 + c0;
#pragma unroll
                    for (int j = 0; j < 8; ++j) d2[j] = cu[0][j]; } }
            if (!prompt && tl >= 30) { float* d2 = p.out + O_CBS + (size_t)sq * 2048 + (size_t)(tl - 30) * 1024 + c0;
#pragma unroll
                for (int j = 0; j < 8; ++j) d2[j] = cu[0][j]; }
        }
        if ((prompt && tl >= 4093) || (!prompt && tl >= 29)) {
            const bf16_t* qr = zq + (size_t)l * 3072;
#pragma unroll
            for (int q = 0; q < 6; ++q) { const int c0 = 8 * lane + 512 * q; float f[8]; unpack8(*(const u32x4*)(qr + c0), f);
                if (prompt) { float* d = (float*)(p.ws + W_HISTA) + (size_t)((seg + 1) * 2 + b) * 9216 + (size_t)(tl - 4093) * 3072 + c0;
#pragma unroll
                    for (int j = 0; j < 8; ++j) d[j] = f[j];
                    if (seg == NSEG - 1) { float* d2 = p.out + O_CAP + (size_t)b * 9216 + (size_t)(tl - 4093) * 3072 + c0;
#pragma unroll
                        for (int j = 0; j < 8; ++j) d2[j] = f[j]; }
                } else { float* d2 = p.out + O_CAS + (size_t)sq * 9216 + (size_t)(tl - 29) * 3072 + c0;
#pragma unroll
                    for (int j = 0; j < 8; ++j) d2[j] = f[j]; }
            }
        }
    }
}
__device__ __forceinline__ void prep_phase(const Params& p, int seg, LAS unsigned char* lds) {
    S1Regs R;
    { const int tid0 = opaque_tid(), w0 = __builtin_amdgcn_readfirstlane(tid0 >> 6);
      if (w0 >= 4 && (int)blockIdx.x < 1088) s1_compute(p, seg, (int)blockIdx.x, w0 - 4, tid0 & 63, R); }
    for (int item = blockIdx.x; item < 1088; item += gridDim.x) prep_item(p, seg, item, item + (int)gridDim.x, R, lds);
    yb_rows(p, seg);
}

constexpr int S_W = 0, S_QD = 17408, S_KD = 34816, S_QK = 53248, S_BUF = 62464;
__device__ __forceinline__ bf16x8 fragP(LAS unsigned char* base, int row, int stride, int t, int g) {
    return *(const LAS bf16x8*)(base + row * stride + (32 * t + 8 * g) * 2);
}
__device__ __forceinline__ bf16x8 pack_frag(const f32x4 a, const f32x4 b) { u32x4 v; v.x = cvt_pk_bf16(a[0], a[1]); v.y = cvt_pk_bf16(a[2], a[3]); v.z = cvt_pk_bf16(b[0], b[1]); v.w = cvt_pk_bf16(b[2], b[3]); return __builtin_bit_cast(bf16x8, v); }

__device__ void scan_phase(const Params& p, int seg, LAS unsigned char* lds, bool dry = false, unsigned* done_ctr = nullptr) {
    const int tid = opaque_tid(), lane = tid & 63, wid = __builtin_amdgcn_readfirstlane(tid >> 6), n = lane & 15, g = lane >> 4;
    bf16_t* oseg = (bf16_t*)(p.ws + W_OSEG);
    const float* glb = (const float*)(p.ws + W_GL);
    const bool remap = gridDim.x >= 240;
    for (int itb = blockIdx.x; itb < (remap ? 240 : 80); itb += gridDim.x) {
        int it = itb;
        if (remap) { if (itb >= 16 && itb < 176) continue; if (itb >= 176) it = 16 + (itb - 176); }
        const bool prompt = it < 16;
        const int b = it >> 3, h = it & 7, sj = (it - 16) >> 3, nsteps = prompt ? 64 : 1, nvalid = prompt ? 64 : 32;
        const float* sin; float* sout;
        if (prompt) { sout = p.out + O_SP + (size_t)(b * 8 + h) * 16384; sin = seg > 0 ? sout : nullptr; }
        else { const int sq = 8 * seg + sj; sin = p.in[3] + (size_t)(sq * 8 + h) * 16384; sout = p.out + O_SS + (size_t)(sq * 8 + h) * 16384; }
        f32x4 S[8];
#pragma unroll
        for (int t = 0; t < 8; ++t)
#pragma unroll
            for (int r = 0; r < 4; ++r) S[t][r] = sin ? sin[(size_t)(16 * t + 4 * g + r) * 128 + 16 * wid + n] : 0.f;
        const int item0 = (prompt ? b * 64 : 128 + sj) * 8 + h;
        const int rowbase0 = prompt ? b * 4096 : 8192 + 32 * sj;
        u32x4 st[2][5], s1[2]; u32x2 un[4]; float gln;
#define SCAN_ISSUE_ST(c_, k_) do { const unsigned char* ob = p.ws + W_OPS + (size_t)(item0 + 8 * (c_)) * OPS_ITEM; \
            _Pragma("unroll") for (int q = 0; q < 5; ++q) { const int v = tid + 512 * q; const size_t so = (q < 4 ? (size_t)v * 16 : 32768 + (size_t)(v - 2048) * 16); st[k_][q] = *(const u32x4*)(ob + so); } } while (0)
#define SCAN_ISSUE_U(c_) do { const unsigned char* ob = p.ws + W_OPS + (size_t)(item0 + 8 * (c_)) * OPS_ITEM; \
            s1[0] = *(const u32x4*)(ob + 32768 + (size_t)(tid + 512 * 5 - 2048) * 16); s1[1] = *(const u32x4*)(ob + 65536 + (size_t)(tid + 512 * 6 - 3072) * 16); \
            _Pragma("unroll") for (int mt = 0; mt < 4; ++mt) un[mt] = *(const u32x2*)(ob + 49152 + (size_t)((16 * wid + n) * 64 + 16 * mt + 4 * g) * 2); \
            gln = glb[item0 + 8 * (c_)]; } while (0)
#define SCAN_COMMIT(buf_, k_) do { LAS unsigned char* cb = lds + (buf_) * S_BUF; \
            _Pragma("unroll") for (int q = 0; q < 7; ++q) { const int v = tid + 512 * q; int off; \
                if (q < 2) off = S_W + (v >> 4) * 272 + (v & 15) * 16; \
                else if (q < 4) off = S_QD + ((v - 1024) >> 4) * 272 + (v & 15) * 16; \
                else if (q < 6) off = S_KD + ((v - 2048) >> 3) * 144 + (v & 7) * 16; \
                else off = S_QK + ((v - 3072) >> 3) * 144 + (v & 7) * 16; \
                *(LAS u32x4*)(cb + off) = q < 5 ? st[k_][q < 5 ? q : 0] : s1[q < 5 ? 0 : q - 5]; } \
            _Pragma("unroll") for (int mt = 0; mt < 4; ++mt) uc[mt] = un[mt]; \
            gl = gln; } while (0)
        u32x2 uc[4]; float gl;
        auto compute = [&](int c) {
            LAS unsigned char* bb = lds + (c & 1) * S_BUF;
            bf16x8 Sb[4];
#pragma unroll
            for (int t = 0; t < 4; ++t) Sb[t] = pack_frag(S[2 * t], S[2 * t + 1]);
            bf16x8 F[2][4]; f32x4 vn[4], ao[4];
#define LD_RW(P, off, mt) do { _Pragma("unroll") for (int t = 0; t < 4; ++t) F[P][t] = fragP(bb + (off), 16 * (mt) + n, 272, t, g); } while (0)
#define LD_PR(P, off, r0) do { F[P][0] = fragP(bb + (off), 16 * (r0) + n, 144, 0, g); F[P][1] = fragP(bb + (off), 16 * (r0) + n, 144, 1, g); \
                               F[P][2] = fragP(bb + (off), 16 * ((r0) + 1) + n, 144, 0, g); F[P][3] = fragP(bb + (off), 16 * ((r0) + 1) + n, 144, 1, g); } while (0)
#define SBAR __builtin_amdgcn_sched_barrier(0)
#define VN_STEP(P, mt) do { f32x4 a = {0.f, 0.f, 0.f, 0.f}; _Pragma("unroll") for (int t = 0; t < 4; ++t) a = __builtin_amdgcn_mfma_f32_16x16x32_bf16(F[P][t], Sb[t], a, 0, 0, 0); \
            vn[mt][0] = bf_lo(uc[mt].x) - a[0]; vn[mt][1] = bf_hi(uc[mt].x) - a[1]; vn[mt][2] = bf_lo(uc[mt].y) - a[2]; vn[mt][3] = bf_hi(uc[mt].y) - a[3]; } while (0)
#define QD_STEP(P, mt) do { f32x4 a = {0.f, 0.f, 0.f, 0.f}; _Pragma("unroll") for (int t = 0; t < 4; ++t) a = __builtin_amdgcn_mfma_f32_16x16x32_bf16(Sb[t], F[P][t], a, 0, 0, 0); ao[mt] = a; } while (0)
#define O_STORE(mt) do { if (16 * (mt) + n < nvalid) { u32x2 w; w.x = cvt_pk_bf16(ao[mt][0], ao[mt][1]); w.y = cvt_pk_bf16(ao[mt][2], ao[mt][3]); \
            *(u32x2*)(oseg + (size_t)(rowb + 16 * (mt) + n) * 1024 + h * 128 + 16 * wid + 4 * g) = w; } } while (0)
#define QK_STEP(P, q) do { ao[2 * (q)] = __builtin_amdgcn_mfma_f32_16x16x32_bf16(vb[0], F[P][0], ao[2 * (q)], 0, 0, 0); ao[2 * (q)] = __builtin_amdgcn_mfma_f32_16x16x32_bf16(vb[1], F[P][1], ao[2 * (q)], 0, 0, 0); \
            ao[2 * (q) + 1] = __builtin_amdgcn_mfma_f32_16x16x32_bf16(vb[0], F[P][2], ao[2 * (q) + 1], 0, 0, 0); ao[2 * (q) + 1] = __builtin_amdgcn_mfma_f32_16x16x32_bf16(vb[1], F[P][3], ao[2 * (q) + 1], 0, 0, 0); \
            O_STORE(2 * (q)); O_STORE(2 * (q) + 1); } while (0)
#define KD_STEP(P, k) do { f32x4 a0 = S[2 * (k)] * gl, a1 = S[2 * (k) + 1] * gl; \
            a0 = __builtin_amdgcn_mfma_f32_16x16x32_bf16(F[P][0], vb[0], a0, 0, 0, 0); a1 = __builtin_amdgcn_mfma_f32_16x16x32_bf16(F[P][2], vb[0], a1, 0, 0, 0); \
            a0 = __builtin_amdgcn_mfma_f32_16x16x32_bf16(F[P][1], vb[1], a0, 0, 0, 0); a1 = __builtin_amdgcn_mfma_f32_16x16x32_bf16(F[P][3], vb[1], a1, 0, 0, 0); S[2 * (k)] = a0; S[2 * (k) + 1] = a1; } while (0)
            const int rowb = rowbase0 + 64 * c;
            LD_RW(0, S_W, 0); SBAR;
            LD_RW(1, S_W, 1); SBAR; VN_STEP(0, 0); SBAR;
            LD_RW(0, S_W, 2); SBAR; VN_STEP(1, 1); SBAR;
            LD_RW(1, S_W, 3); SBAR; VN_STEP(0, 2); SBAR;
            LD_RW(0, S_QD, 0); SBAR; VN_STEP(1, 3); SBAR;
            bf16x8 vb[2]; vb[0] = pack_frag(vn[0], vn[1]); vb[1] = pack_frag(vn[2], vn[3]);
            LD_RW(1, S_QD, 1); SBAR; QD_STEP(0, 0); SBAR;
            LD_RW(0, S_QD, 2); SBAR; QD_STEP(1, 1); SBAR;
            LD_RW(1, S_QD, 3); SBAR; QD_STEP(0, 2); SBAR;
            LD_PR(0, S_QK, 0); SBAR; QD_STEP(1, 3); SBAR;
            LD_PR(1, S_QK, 2); SBAR; QK_STEP(0, 0); SBAR;
            LD_PR(0, S_KD, 0); SBAR; QK_STEP(1, 1); SBAR;
            LD_PR(1, S_KD, 2); SBAR; KD_STEP(0, 0); SBAR;
            LD_PR(0, S_KD, 4); SBAR; KD_STEP(1, 1); SBAR;
            LD_PR(1, S_KD, 6); SBAR; KD_STEP(0, 2); SBAR;
            KD_STEP(1, 3); SBAR;
#undef LD_RW
#undef LD_PR
#undef SBAR
#undef VN_STEP
#undef QD_STEP
#undef O_STORE
#undef QK_STEP
#undef KD_STEP
        };
        SCAN_ISSUE_ST(0, 0); SCAN_ISSUE_U(0); SCAN_COMMIT(0, 0);
        if (nsteps > 1) SCAN_ISSUE_ST(1, 1);
        if (nsteps > 2) SCAN_ISSUE_ST(2, 0);
        lds_barrier();
        for (int c = 0; c < nsteps; c += 2) {
            if (c + 1 < nsteps) SCAN_ISSUE_U(c + 1);
            compute(c);
            if (c + 1 < nsteps) SCAN_COMMIT(1, 1);
            if (c + 3 < nsteps) SCAN_ISSUE_ST(c + 3, 1);
            lds_barrier();
            if (c + 1 >= nsteps) break;
            if (c + 2 < nsteps) SCAN_ISSUE_U(c + 2);
            compute(c + 1);
            if (c + 2 < nsteps) SCAN_COMMIT(0, 0);
            if (c + 4 < nsteps) SCAN_ISSUE_ST(c + 4, 0);
            lds_barrier();
        }
#undef SCAN_ISSUE_ST
#undef SCAN_ISSUE_U
#undef SCAN_COMMIT
#pragma unroll
        for (int t = 0; t < 8; ++t)
#pragma unroll
            for (int r = 0; r < 4; ++r) { if (!dry) sout[(size_t)(16 * t + 4 * g + r) * 128 + 16 * wid + n] = S[t][r]; }
        if (done_ctr) {
            asm volatile("s_waitcnt vmcnt(0)" ::: "memory"); __syncthreads();
            if (threadIdx.x == 0) { __builtin_amdgcn_fence(__ATOMIC_RELEASE, "agent"); asm volatile("s_waitcnt vmcnt(0)" ::: "memory");
                (void)__hip_atomic_fetch_add(done_ctr, 1u, __ATOMIC_RELAXED, __HIP_MEMORY_SCOPE_AGENT); }
        }
    }
}

__device__ void ya_phase(const Params& p, int seg, int skipb = 0) {
    if ((int)blockIdx.x < skipb) return;
    const int tid = opaque_tid(), lane = tid & 63, wid = tid >> 6, gw = ((int)blockIdx.x - skipb) * 8 + wid, nW = ((int)gridDim.x - skipb) * 8;
    const bf16_t* oseg = (const bf16_t*)(p.ws + W_OSEG); bf16_t* za = (bf16_t*)(p.ws + W_BUFA);
    for (int l = gw; l < SEGM; l += nW) {
        const size_t R = (size_t)seg * SEGM + l; const int c0 = 16 * lane;
        float o[16], z[16];
        unpack8(*(const u32x4*)(oseg + (size_t)l * 1024 + c0), o); unpack8(*(const u32x4*)(oseg + (size_t)l * 1024 + c0 + 8), o + 8);
        unpack8(*(const u32x4*)(za + R * 1024 + c0), z); unpack8(*(const u32x4*)(za + R * 1024 + c0 + 8), z + 8);
        float ss = 0.f;
#pragma unroll
        for (int j = 0; j < 16; ++j) ss += o[j] * o[j];
        ss += __shfl_xor(ss, 1); ss += __shfl_xor(ss, 2); ss += __shfl_xor(ss, 4);
        const float rs = rsqrtf(ss * (1.0f / 128.0f) + 1e-6f);
        float y[16];
#pragma unroll
        for (int j = 0; j < 16; ++j) y[j] = o[j] * rs * p.in[13][(c0 + j) & 127] * siluf_(z[j]);
        *(u32x4*)(za + R * 1024 + c0) = pack8(y); *(u32x4*)(za + R * 1024 + c0 + 8) = pack8(y + 8);
    }
}
__device__ void ln1_phase(const Params& p) {
    const int tid = opaque_tid(), lane = tid & 63, wid = tid >> 6, gw = blockIdx.x * 8 + wid, nW = gridDim.x * 8;
    bf16_t* h1 = (bf16_t*)(p.ws + W_BUFA);
    for (int r = gw; r < MROWS; r += nW) { float o[16]; ln_row_bf16in((const bf16_t*)p.out + (size_t)r * 1024, p.in[18], p.in[19], lane, o); store_row_bf16(h1 + (size_t)r * 1024, lane, o); }
}
__device__ void ln2_phase(const Params& p) {
    const int tid = opaque_tid(), lane = tid & 63, wid = tid >> 6, gw = blockIdx.x * 8 + wid, nW = gridDim.x * 8;
    for (int r = gw; r < MROWS; r += nW) { float o[16]; float* x = p.out + (size_t)row2tok(r) * 1024; ln_row_bf16in((const bf16_t*)(p.ws + W_BUFB) + (size_t)r * 1024, p.in[22], p.in[23], lane, o);
#pragma unroll
        for (int k = 0; k < 4; ++k) __builtin_nontemporal_store((f32x4)((f32x4){o[4 * k], o[4 * k + 1], o[4 * k + 2], o[4 * k + 3]}), (f32x4*)(x + 4 * lane + 256 * k)); }
}

#define XB_TMO      128
#define XB_XCNT(j)  (256  + 64 * (j))
#define XB_XSUB(j)  (1280 + 64 * (j))
#define XB_XGEN(j)  (2304 + 64 * (j))
#define XB_TOP      3328
#define XB_TOPGEN   3392
#define XCD_BAR_WORDS 3456
#define XB_SPIN_CAP (1u << 20)
__device__ __forceinline__ unsigned xb_ld(unsigned* p)              { return __hip_atomic_load(p, __ATOMIC_RELAXED, __HIP_MEMORY_SCOPE_AGENT); }
__device__ __forceinline__ unsigned xb_add(unsigned* p, unsigned v) { return __hip_atomic_fetch_add(p, v, __ATOMIC_RELAXED, __HIP_MEMORY_SCOPE_AGENT); }
__device__ __forceinline__ unsigned xb_xcc_id() { return (unsigned)__builtin_amdgcn_s_getreg((3 << 11) | 20) & 0xFu; }
#define XB_SPIN(cond, bar) do { unsigned _sp = 0; while (cond) { __builtin_amdgcn_s_sleep(1); \
    if ((++_sp & 255u) == 0u) { if (xb_ld(&(bar)[XB_TMO])) break; if (_sp > XB_SPIN_CAP) { atomicAdd(&(bar)[XB_TMO], 1u); break; } } } } while (0)
struct XcdBarrier { unsigned* bar; unsigned x; volatile LAS unsigned* st; };
__device__ __forceinline__ XcdBarrier xcd_barrier_post(unsigned* bar, volatile LAS unsigned* st) {
    XcdBarrier b; b.bar = bar; b.x = xb_xcc_id(); b.st = st;
    if (threadIdx.x == 0) (void)xb_add(&bar[XB_XCNT(b.x)], 1u);
    return b;
}
__device__ __forceinline__ void xcd_barrier_complete(unsigned* bar, unsigned x, unsigned& nloc, unsigned& nx) {
    const unsigned G = gridDim.x * gridDim.y * gridDim.z;
    unsigned sum, cnt, mine, sp = 0u;
    for (;;) {
        sum = 0u; cnt = 0u; mine = 0u;
#pragma unroll
        for (unsigned j = 0; j < 16; ++j) { const unsigned c = xb_ld(&bar[XB_XCNT(j)]); sum += c; cnt += (c > 0u) ? 1u : 0u; mine = (j == x) ? c : mine; }
        if (sum == G) break;
        __builtin_amdgcn_s_sleep(1);
        if ((++sp & 255u) == 0u) { if (xb_ld(&bar[XB_TMO])) break; if (sp > XB_SPIN_CAP) { atomicAdd(&bar[XB_TMO], 1u); break; } }
    }
    nloc = mine > 0u ? mine : 1u; nx = cnt > 0u ? cnt : 1u;
}
__device__ __forceinline__ void xcd_barrier(const XcdBarrier& b) {
    asm volatile("s_waitcnt vmcnt(0)" ::: "memory");
    __syncthreads();
    if (threadIdx.x == 0) {
        unsigned* bar = b.bar;
        __builtin_amdgcn_s_waitcnt(0);
        unsigned nloc = b.st[0], nx = b.st[1];
        if (nloc == 0u) { xcd_barrier_complete(bar, b.x, nloc, nx); b.st[0] = nloc; b.st[1] = nx; }
        const unsigned old = xb_add(&bar[XB_XSUB(b.x)], 1u);
        const unsigned gen = old / nloc;
        if (old + 1u == (gen + 1u) * nloc) {
            __builtin_amdgcn_fence(__ATOMIC_RELEASE, "agent");
            asm volatile("s_waitcnt vmcnt(0)" ::: "memory");
            const unsigned og = xb_add(&bar[XB_TOP], 1u);
            const unsigned tg = og / nx;
            if (og + 1u == (tg + 1u) * nx) xb_add(&bar[XB_TOPGEN], 1u);
            else XB_SPIN(xb_ld(&bar[XB_TOPGEN]) == tg, bar);
            __builtin_amdgcn_fence(__ATOMIC_ACQUIRE, "agent");
            xb_add(&bar[XB_XGEN(b.x)], 1u);
            asm volatile("s_waitcnt vmcnt(0)" ::: "memory");
        } else {
            XB_SPIN(xb_ld(&bar[XB_XGEN(b.x)]) == gen, bar);
            __builtin_amdgcn_fence(__ATOMIC_ACQUIRE, "agent");
            asm volatile("s_waitcnt vmcnt(0)" ::: "memory");
        }
    }
    __syncthreads();
}

__global__ void __launch_bounds__(512, 2) mk_fwd(Params p) {
    extern __shared__ __attribute__((aligned(16))) unsigned char shm[];
    LAS unsigned char* lds = (LAS unsigned char*)shm;
    cg::grid_group grid = cg::this_grid();
    unsigned char* ws = p.ws;
    volatile LAS unsigned* stw = (volatile LAS unsigned*)(lds + 131072);
    if (threadIdx.x == 0) { stw[0] = 0u; stw[1] = 0u; }
    __syncthreads();
    const XcdBarrier xb = xcd_barrier_post((unsigned*)(ws + W_BAR), stw);
    for (int ph = p.ph_lo; ph < p.ph_hi; ++ph) {
      for (int rep = 0; rep < (ph == REP_PH ? REP_N : 1); ++rep) {
        if (rep > 0) grid.sync();
        if (ph == 0) phase0(p);
        else if (ph == 1 || (ph >= 3 && ph <= 7 && (ph & 1))) {
            const int seg = ph == 1 ? 0 : ((ph - 3) >> 1) + 1, skip = ph == 1 ? 0 : 16;
            if (REP_PH == 103 && ph == 3) scan_phase(p, seg - 1, lds, true);
            if (ph != 1 && rep == 0) scan_phase(p, seg - 1, lds);
            F1 f{(bf16_t*)(ws + W_ZQ), (bf16_t*)(ws + W_BUFA), (bf16_t*)(ws + W_ZB4), (bf16_t*)p.out, (float*)(ws + W_BD), seg};
            run_gemm(lds, (const bf16_t*)(ws + W_HBF) + (size_t)seg * SEGM * 1024, (const bf16_t*)(ws + W_WIN), SEGM, NZ, 1024, f, skip);
            if (ph == 1) {
                const int G = (int)gridDim.x, rem = ((SEGM / 256) * (NZ / 256)) % G, first = rem;
                if ((int)blockIdx.x >= first) { const int t2 = opaque_tid(); ln_in_rows(p, SEGM, MROWS, ((int)blockIdx.x - first) * 8 + (t2 >> 6), (G - first) * 8, t2 & 63);
                    cvt_small_weights(p, ((int)blockIdx.x - first) * 8 + (t2 >> 6), (G - first) * 8, t2 & 63); }
            }
        }
        else if (ph >= 2 && ph <= 8) { const int seg = (ph - 2) >> 1; prep_phase(p, seg, lds); if (seg > 0) ya_phase(p, seg - 1, gridDim.x > 128 ? 64 : 0); }
        else if (ph == 9) { unsigned* ctr = (unsigned*)(ws + W_BAR) + 64;
            scan_phase(p, 3, lds, false, ctr);
            FB f{(bf16_t*)(ws + W_ZB4), (const bf16_t*)p.out}; run_gemm(lds, (const bf16_t*)(ws + W_BUFB), (const bf16_t*)(ws + W_WB), MROWS, 1024, 1024, f, 16);
            if ((int)blockIdx.x >= 64) {
                if (threadIdx.x == 0) { unsigned sp = 0; while (__hip_atomic_load(ctr, __ATOMIC_RELAXED, __HIP_MEMORY_SCOPE_AGENT) < 80u) { __builtin_amdgcn_s_sleep(4); if (++sp > (1u << 24)) break; }
                    __builtin_amdgcn_fence(__ATOMIC_ACQUIRE, "agent"); asm volatile("s_waitcnt vmcnt(0)" ::: "memory"); }
                __syncthreads();
                ya_phase(p, 3, 64);
            } }
        else if (ph == 10) { FA f{(bf16_t*)(ws + W_ZB4), (const bf16_t*)p.out}; run_gemm(lds, (const bf16_t*)(ws + W_BUFA), (const bf16_t*)(ws + W_WA), MROWS, 1024, 1024, f); }
        else if (ph == 11) { FO f{(bf16_t*)p.out, (const bf16_t*)(ws + W_HBF)}; run_gemm(lds, (const bf16_t*)(ws + W_ZB4), (const bf16_t*)(ws + W_WO), MROWS, 1024, 1024, f);
            FP2 f2{(bf16_t*)(ws + W_OPS)}; run_gemm(lds, (const bf16_t*)(ws + W_PBF), (const bf16_t*)(ws + W_WP), MROWS, 1024, 256, f2, 16); }
        else if (ph == 12) ln1_phase(p);
        else if (ph == 13) { FG2 f{(bf16_t*)(ws + W_BUFB), (const bf16_t*)(ws + W_BUFA), (const bf16_t*)(ws + W_OPS)}; run_gemm(lds, (const bf16_t*)(ws + W_BUFA), (const bf16_t*)(ws + W_WG), MROWS, 1024, 1024, f); }
        else ln2_phase(p);
      }
        if (ph + 1 < p.ph_hi) { if (p.ph_hi > NPH) grid.sync(); else xcd_barrier(xb); }
        if (REP_PH == 100 && ph == 10) { for (int q = 0; q < 20; ++q) grid.sync(); }
    }
    if (DBG_SKIP && p.ph_hi == NPH) {
        const size_t i0 = (size_t)blockIdx.x * 512 + threadIdx.x, st = (size_t)gridDim.x * 512;
        for (size_t i = i0; i < O_CAP; i += st) p.out[i] = 0.f;
        if (DBG_SKIP == 1) { for (size_t i = i0; i < 262144; i += st) p.out[O_SP + i] = 0.f; for (size_t i = i0; i < 4194304; i += st) p.out[O_SS + i] = 0.f; }
        if (DBG_SKIP >= 3) { for (size_t i = i0; i < 262144; i += st) p.out[O_SP + i] = 0.f; }
    }
}

extern "C" void kernel_launch(void* const* d_in, const int* in_sizes, int n_in, void* d_out, int out_size, void* d_ws, size_t ws_size, hipStream_t stream) {
    static int grid = 0;
    if (grid == 0) {
        if (n_in != 24 || out_size != 39442432 || ws_size < W_END) { fprintf(stderr, "kernel_launch: unexpected shapes (n_in %d out %d ws %zu need %zu)\n", n_in, out_size, ws_size, (size_t)W_END); grid = -1; return; }
        int dev = 0, cus = 0, per_cu = 0;
        hipGetDevice(&dev); hipDeviceGetAttribute(&cus, hipDeviceAttributeMultiprocessorCount, dev);
        if (hipFuncSetAttribute((const void*)mk_fwd, hipFuncAttributeMaxDynamicSharedMemorySize, LDS_BYTES) != hipSuccess) { fprintf(stderr, "hipFuncSetAttribute failed\n"); grid = -1; return; }
        if (hipOccupancyMaxActiveBlocksPerMultiprocessor(&per_cu, (const void*)mk_fwd, 512, LDS_BYTES) != hipSuccess || per_cu < 1) { fprintf(stderr, "occupancy query failed (%d)\n", per_cu); grid = -1; return; }
        grid = cus * 1;
        fprintf(stderr, "kernel_launch: grid %d (per_cu %d), ws need %zu have %zu\n", grid, per_cu, (size_t)W_END, ws_size);
    }
    if (grid < 0) return;
    if (hipMemsetAsync((char*)d_ws + W_BAR, 0, 16384, stream) != hipSuccess) { fprintf(stderr, "kernel_launch: memset of barrier words failed\n"); return; }
    Params p{};
    for (int i = 0; i < 24; ++i) p.in[i] = (const float*)d_in[i];
    p.out = (float*)d_out; p.ws = (unsigned char*)d_ws;
#if MK_MULTI
    for (int ph = 0; ph < NPH; ++ph) { p.ph_lo = ph; p.ph_hi = ph + 1; hipLaunchKernelGGL(mk_fwd, dim3(grid), dim3(512), LDS_BYTES, stream, p); }
#else
    p.ph_lo = 0; p.ph_hi = NPH;
    void* args[] = {&p};
    hipError_t e = hipLaunchCooperativeKernel((void*)mk_fwd, dim3(grid), dim3(512), args, LDS_BYTES, stream);
    if (e != hipSuccess) fprintf(stderr, "cooperative launch failed: %s (grid %d)\n", hipGetErrorString(e), grid);
#endif
}
```
